# Optimizing an MI355X kernel written in HIP

```python
import jax, jax.numpy as jnp
from jax import lax
import numpy as np

D_MODEL = 1024
BATCH = 16
SEQ = 4096
DEPTH = 4
DEC_BATCH = 8
DEC_SEQ = 16
PAST_LEN = 1024

CHUNK = 64
D_MIX = D_MODEL
SSD_WIDTH = D_MIX // 2
SSD_HEAD_DIM = 64
SSD_HEADS = SSD_WIDTH // SSD_HEAD_DIM
SSD_GROUPS = 2
SSD_HPG = SSD_HEADS // SSD_GROUPS
D_STATE = 128
CONV_W = 4
CONV_DIM = SSD_WIDTH + 2 * SSD_GROUPS * D_STATE
SSD_CHUNK = CHUNK
CMLP_WIDTH = D_MIX - SSD_WIDTH
CMLP_GROUPS = 4
CMLP_GDIM = CMLP_WIDTH // CMLP_GROUPS
CMLP_CHUNK = 128
D_FF = 4 * D_MODEL
N_MOD = 6
IN_DIM = SSD_WIDTH + CONV_DIM + SSD_HEADS + 2 * CMLP_WIDTH
RMS_EPS = 1e-6
LN_EPS = 1e-5

kernel_name = 'hybrid_ssd_chunkmlp_stream_step'


def rms_norm(x, g):
    xf = x.astype(jnp.float32)
    y = xf * lax.rsqrt(jnp.mean(xf * xf, axis=-1, keepdims=True) + RMS_EPS)
    return (y * g.astype(jnp.float32)).astype(x.dtype)


def layer_norm(x, g, b):
    xf = x.astype(jnp.float32)
    mu = jnp.mean(xf, axis=-1, keepdims=True)
    xc = xf - mu
    y = xc * lax.rsqrt(jnp.mean(xc * xc, axis=-1, keepdims=True) + LN_EPS)
    return (y * g.astype(jnp.float32) + b.astype(jnp.float32)).astype(x.dtype)


def causal_conv(xbc, cache, w, b):
    L = xbc.shape[1]
    xp = jnp.concatenate([cache.astype(xbc.dtype), xbc], axis=1)
    out = b
    for k in range(CONV_W):
        out = out + w[k] * xp[:, k:k + L]
    return jax.nn.silu(out), xp[:, -(CONV_W - 1):]


def ssd_scan(x, dt, A, Bm, Cm, h0):
    b, L = x.shape[:2]
    Q = min(SSD_CHUNK, L)
    nc = L // Q
    x = x.reshape(b, nc, Q, SSD_GROUPS, SSD_HPG, SSD_HEAD_DIM)
    dt = dt.reshape(b, nc, Q, SSD_GROUPS, SSD_HPG)
    Bm = Bm.reshape(b, nc, Q, SSD_GROUPS, D_STATE)
    Cm = Cm.reshape(b, nc, Q, SSD_GROUPS, D_STATE)
    a_cum = jnp.cumsum(dt * A.reshape(SSD_GROUPS, SSD_HPG), axis=2)
    seg = a_cum[:, :, :, None] - a_cum[:, :, None, :]
    mask = jnp.tril(jnp.ones((Q, Q), dtype=bool))[:, :, None, None]
    decay = jnp.exp(jnp.where(mask, seg, -jnp.inf))
    cb = jnp.einsum('bcign,bcjgn->bcijg', Cm, Bm)
    xdt = x * dt[..., None]
    y_diag = jnp.einsum('bcijg,bcijgr,bcjgrp->bcigrp', cb, decay, xdt)
    a_last = a_cum[:, :, -1]
    w_end = jnp.exp(a_last[:, :, None] - a_cum) * dt
    states = jnp.einsum('bcjgn,bcjgr,bcjgrp->bcgrpn', Bm, w_end, x)

    def step(h, inp):
        s, al = inp
        return jnp.exp(al)[..., None, None] * h + s, h

    h0 = h0.reshape(b, SSD_GROUPS, SSD_HPG, SSD_HEAD_DIM, D_STATE)
    h_fin, h_in = lax.scan(step, h0, (jnp.moveaxis(states, 1, 0), jnp.moveaxis(a_last, 1, 0)))
    h_in = jnp.moveaxis(h_in, 0, 1)
    y_off = jnp.einsum('bcign,bcgrpn,bcigr->bcigrp', Cm, h_in, jnp.exp(a_cum))
    y = (y_diag + y_off).reshape(b, L, SSD_HEADS, SSD_HEAD_DIM)
    return y, h_fin.reshape(b, SSD_HEADS, SSD_HEAD_DIM, D_STATE)


def mixer(h, conv_cache, ssd_h0, w_in, conv_w, conv_b, dt_bias, a_log, d_skip,
          ssd_norm_g, v_ln_g, v_ln_b, w_s, b_s, w_out):
    b, L, _ = h.shape
    f32 = jnp.float32
    proj = h @ w_in
    z, xbc, dt_raw, uv = jnp.split(
        proj, [SSD_WIDTH, SSD_WIDTH + CONV_DIM, SSD_WIDTH + CONV_DIM + SSD_HEADS], axis=-1)
    xbc_act, conv_state = causal_conv(xbc, conv_cache, conv_w, conv_b)
    xs, Bm, Cm = jnp.split(xbc_act, [SSD_WIDTH, SSD_WIDTH + SSD_GROUPS * D_STATE], axis=-1)
    dt = jax.nn.softplus(dt_raw.astype(f32) + dt_bias.astype(f32))
    A = -jnp.exp(a_log.astype(f32))
    xh = xs.astype(f32).reshape(b, L, SSD_HEADS, SSD_HEAD_DIM)
    y, h_fin = ssd_scan(xh, dt, A,
                        Bm.astype(f32).reshape(b, L, SSD_GROUPS, D_STATE),
                        Cm.astype(f32).reshape(b, L, SSD_GROUPS, D_STATE),
                        ssd_h0.astype(f32))
    y = y + d_skip.astype(f32)[:, None] * xh
    y = y.reshape(b, L, SSD_WIDTH) * jax.nn.silu(z.astype(f32))
    y_ssd = rms_norm(y, ssd_norm_g).astype(h.dtype)
    u, v = jnp.split(jax.nn.gelu(uv), 2, axis=-1)
    v = layer_norm(v, v_ln_g, v_ln_b)
    Q = min(CMLP_CHUNK, L)
    nk = L // Q
    vq = v.reshape(b, nk, Q, CMLP_GROUPS, CMLP_GDIM)
    ws = jnp.tril(w_s[:, :Q, :Q])
    mixed = jnp.einsum('gij,bkjgd->bkigd', ws, vq) + b_s[:, :Q].T[None, None, :, :, None]
    y_cmlp = (u.reshape(b, nk, Q, CMLP_GROUPS, CMLP_GDIM) * mixed).reshape(b, L, CMLP_WIDTH)
    out = jnp.concatenate([y_ssd, y_cmlp.astype(h.dtype)], axis=-1) @ w_out
    return out, conv_state, h_fin, v


def block(x, c, conv_cache, ssd_h0, w_mod, b_mod, norm_g, w_in, conv_w, conv_b, dt_bias,
          a_log, d_skip, ssd_norm_g, v_ln_g, v_ln_b, w_s, b_s, w_out, w_ff1, w_ff2):
    mod = (jax.nn.silu(c) @ w_mod + b_mod)[:, None, :]
    sh1, sc1, g1, sh2, sc2, g2 = jnp.split(mod, N_MOD, axis=-1)
    h = rms_norm(x, norm_g[0]) * (1 + sc1) + sh1
    m, conv_state, h_fin, v = mixer(h, conv_cache, ssd_h0, w_in, conv_w, conv_b, dt_bias,
                                    a_log, d_skip, ssd_norm_g, v_ln_g, v_ln_b, w_s, b_s, w_out)
    x = x + g1 * rms_norm(m, norm_g[1])
    h = rms_norm(x, norm_g[2]) * (1 + sc2) + sh2
    f = jnp.square(jax.nn.relu(h @ w_ff1)) @ w_ff2
    x = x + g2 * rms_norm(f, norm_g[3])
    return x, conv_state, h_fin.astype(x.dtype), v


def setup_inputs(seed: int = 0) -> dict:
    key = jax.random.key(seed)
    ks = jax.random.split(key, 24)
    nrm = jax.random.normal
    dt0 = jnp.exp(jax.random.uniform(ks[10], (DEPTH, SSD_HEADS), minval=np.log(1e-3), maxval=np.log(1e-1)))
    return {
        'x_prompt': nrm(ks[0], (BATCH, SEQ, D_MODEL), jnp.float32),
        'x_sample': nrm(ks[1], (DEC_BATCH, DEC_SEQ, D_MODEL), jnp.float32),
        'state_conv': nrm(ks[2], (DEPTH, DEC_BATCH, CONV_W - 1, CONV_DIM), jnp.float32),
        'state_ssd': 0.1 * nrm(ks[3], (DEPTH, DEC_BATCH, SSD_HEADS, SSD_HEAD_DIM, D_STATE), jnp.float32),
        'c_prompt': nrm(ks[4], (BATCH, D_MODEL), jnp.float32),
        'c_sample': nrm(ks[5], (DEC_BATCH, D_MODEL), jnp.float32),
        'w_mod': 0.5 * D_MODEL ** -0.5 * nrm(ks[6], (DEPTH, D_MODEL, N_MOD * D_MODEL), jnp.float32),
        'b_mod': 0.01 * nrm(ks[7], (DEPTH, N_MOD * D_MODEL), jnp.float32),
        'norm_g': 1.0 + 0.02 * nrm(ks[8], (DEPTH, 4, D_MODEL), jnp.float32),
        'w_in': D_MODEL ** -0.5 * nrm(ks[9], (DEPTH, D_MODEL, IN_DIM), jnp.float32),
        'conv_w': CONV_W ** -0.5 * nrm(ks[11], (DEPTH, CONV_W, CONV_DIM), jnp.float32),
        'conv_b': 0.02 * nrm(ks[12], (DEPTH, CONV_DIM), jnp.float32),
        'dt_bias': dt0 + jnp.log(-jnp.expm1(-dt0)),
        'a_log': jnp.log(jax.random.uniform(ks[13], (DEPTH, SSD_HEADS), minval=1.0, maxval=16.0)),
        'd_skip': 1.0 + 0.1 * nrm(ks[14], (DEPTH, SSD_HEADS), jnp.float32),
        'ssd_norm_g': 1.0 + 0.02 * nrm(ks[15], (DEPTH, SSD_WIDTH), jnp.float32),
        'v_ln_g': 1.0 + 0.02 * nrm(ks[16], (DEPTH, CMLP_WIDTH), jnp.float32),
        'v_ln_b': 0.02 * nrm(ks[17], (DEPTH, CMLP_WIDTH), jnp.float32),
        'w_s': CMLP_CHUNK ** -0.5 * nrm(ks[18], (DEPTH, CMLP_GROUPS, CMLP_CHUNK, CMLP_CHUNK), jnp.float32),
        'b_s': 1.0 + 0.02 * nrm(ks[19], (DEPTH, CMLP_GROUPS, CMLP_CHUNK), jnp.float32),
        'w_out': D_MIX ** -0.5 * nrm(ks[20], (DEPTH, D_MIX, D_MODEL), jnp.float32),
        'w_ff1': D_MODEL ** -0.5 * nrm(ks[21], (DEPTH, D_MODEL, D_FF), jnp.float32),
        'w_ff2': D_FF ** -0.5 * nrm(ks[22], (DEPTH, D_FF, D_MODEL), jnp.float32),
    }


def reference(x_prompt, x_sample, state_conv, state_ssd, c_prompt, c_sample, w_mod, b_mod,
              norm_g, w_in, conv_w, conv_b, dt_bias, a_log, d_skip, ssd_norm_g, v_ln_g,
              v_ln_b, w_s, b_s, w_out, w_ff1, w_ff2):
    bp = x_prompt.shape[0]
    conv_p0 = jnp.zeros((bp, CONV_W - 1, CONV_DIM), x_prompt.dtype)
    ssd_p0 = jnp.zeros((bp, SSD_HEADS, SSD_HEAD_DIM, D_STATE), jnp.float32)
    xp, xs = x_prompt, x_sample
    conv_p, ssd_p, conv_s, ssd_s, v_s = [], [], [], [], []
    for l in range(DEPTH):
        lp = [w[l] for w in (w_mod, b_mod, norm_g, w_in, conv_w, conv_b, dt_bias, a_log, d_skip,
                             ssd_norm_g, v_ln_g, v_ln_b, w_s, b_s, w_out, w_ff1, w_ff2)]
        xp, cp, hp, _ = block(xp, c_prompt, conv_p0, ssd_p0, *lp)
        xs, cs, hs, vs = block(xs, c_sample, state_conv[l], state_ssd[l], *lp)
        conv_p.append(cp)
        ssd_p.append(hp)
        conv_s.append(cs)
        ssd_s.append(hs)
        v_s.append(vs)
    return (xp, xs, jnp.stack(conv_p), jnp.stack(ssd_p), jnp.stack(conv_s), jnp.stack(ssd_s), jnp.stack(v_s))
```

```cpp
#include <hip/hip_runtime.h>
#include <hip/hip_cooperative_groups.h>
#include <cstdio>
#include <cstdint>
namespace cg = cooperative_groups;
namespace pg8 {
#define PG8_LAS __attribute__((address_space(3)))
typedef unsigned short bf16_t;
typedef short bf16x8 __attribute__((ext_vector_type(8)));
typedef float f32x4 __attribute__((ext_vector_type(4)));
typedef unsigned u32x4 __attribute__((ext_vector_type(4)));
constexpr int BM = 256, BK = 64, HALF = 128, HTB = HALF * BK * 2  , STAGE_BYTES = 8 * HTB, NXCD = 8, WGM = 8;

__host__ __device__ __forceinline__ int lds_byte(int r, int c) { const int st = (r >> 4) * 2 + (c >> 5), rr = r & 15, cc = c & 31, ob = rr * 64 + cc * 2; return st * 1024 + (ob ^ (((ob >> 9) & 1) << 5)); }
__host__ __device__ __forceinline__ void stage_rc(int b, int& R, int& C) { const int st = b / 1024, sb = b % 1024, swz = sb ^ (((sb >> 9) & 1) << 5); R = (st >> 1) * 16 + swz / 64; C = (st & 1) * 32 + (swz % 64) / 2; }
__host__ __device__ __forceinline__ int perm32(int rho) { const int n = rho >> 4, i = rho & 15; return 8 * (i >> 2) + 4 * n + (i & 3); }

struct Unit { int pm, pn; };
struct Gemm { const bf16_t* A; const bf16_t* Bt; int M, N, K; };

struct StaticOrder {
    int nM, nN, nwg, G, c;
    __host__ __device__ void init(int M, int N, int G_, int c_) { nM = M / BM; nN = N / BM; nwg = nM * nN; G = G_; c = c_; }
    __host__ __device__ bool next(int i, Unit& u) const {
        const long L = (long)i * G + c; if (L >= nwg) return false;
        int wgid = (int)L; { const int q = nwg / NXCD, r = nwg % NXCD, xcd = wgid % NXCD, off = wgid / NXCD; wgid = (xcd < r ? xcd * (q + 1) : r * (q + 1) + (xcd - r) * q) + off; }
        const int nig = WGM * nN, gid = wgid / nig, fm = gid * WGM, gsz = (nM - fm) < WGM ? (nM - fm) : WGM;
        u.pm = fm + ((wgid % nig) % gsz); u.pn = (wgid % nig) / gsz; return true;
    }
    __device__ __forceinline__ void a_ready(const Unit&) const {}
    __device__ __forceinline__ void done(const Unit&) const {}
};

__device__ __forceinline__ unsigned cvt_pk_bf16(float lo, float hi) { unsigned r; asm volatile("v_cvt_pk_bf16_f32 %0, %1, %2" : "=v"(r) : "v"(lo), "v"(hi)); return r; }
__device__ __forceinline__ float gelu_tanh_f(float x) {
    const float t = x * (1.5957691216f + 0.0713548163f * x * x);
    return x * __builtin_amdgcn_rcpf(1.0f + __builtin_amdgcn_exp2f(-1.4426950409f * t));
}
struct EpiAct {
    static constexpr bool PERM = true, AFTER_DRAIN = false;
    bf16_t* O; int ldc; int mode; int act_pn;
    __device__ __forceinline__ void operator()(const f32x4 (&acc)[2][2][4][2], const Unit& u, int wr, int wc, int fr, int fq) const {
        const int row0 = u.pm * BM + wr * 64 + fr; const int col0 = u.pn * BM + wc * 32 + 8 * fq;
        const int act = ((mode & 3) == 2) ? 2 : (((mode & 3) == 1 && u.pn >= act_pn) ? 1 : (((mode & 3) == 1 && u.pn < 2) ? 3 : 0));
#pragma unroll
        for (int ai = 0; ai < 2; ++ai)
#pragma unroll
            for (int m = 0; m < 4; ++m) { bf16_t* rowp = O + (size_t)(row0 + ai * HALF + m * 16) * ldc + col0;
#pragma unroll
                for (int bj = 0; bj < 2; ++bj) { f32x4 v0 = acc[ai][bj][m][0], v1 = acc[ai][bj][m][1];
                    if (act == 1) {
#pragma unroll
                        for (int j = 0; j < 4; ++j) { v0[j] = gelu_tanh_f(v0[j]); v1[j] = gelu_tanh_f(v1[j]); } }
                    else if (act == 2) {
#pragma unroll
                        for (int j = 0; j < 4; ++j) { const float a0 = fmaxf(v0[j], 0.f), a1 = fmaxf(v1[j], 0.f); v0[j] = a0 * a0; v1[j] = a1 * a1; } }
                    else if (act == 3) {
#pragma unroll
                        for (int j = 0; j < 4; ++j) { v0[j] = v0[j] * __builtin_amdgcn_rcpf(1.0f + __builtin_amdgcn_exp2f(-1.4426950409f * v0[j])); v1[j] = v1[j] * __builtin_amdgcn_rcpf(1.0f + __builtin_amdgcn_exp2f(-1.4426950409f * v1[j])); } }
                    u32x4 w; w.x = cvt_pk_bf16(v0[0], v0[1]); w.y = cvt_pk_bf16(v0[2], v0[3]); w.z = cvt_pk_bf16(v1[0], v1[1]); w.w = cvt_pk_bf16(v1[2], v1[3]);
                    if ((mode & 3) != 2) __builtin_nontemporal_store(w, (u32x4*)(rowp + bj * HALF)); else *(u32x4*)(rowp + bj * HALF) = w; } }
    }
};

template <class Epi, class Sched, bool ALIGN_EPI = false, bool SP2 = false>
__device__ __forceinline__ void gemm_phase(PG8_LAS unsigned char* lds, const Gemm g, const Sched& S, const Epi& E) {
    int tid_ = threadIdx.x; asm volatile("" : "+v"(tid_));
    const int tid = tid_, wid = __builtin_amdgcn_readfirstlane(tid >> 6), lane = tid & 63, wr = wid >> 2, wc = wid & 3, fr = lane & 15, fq = lane >> 4;
    const int K = g.K, nt = K / BK;
    unsigned voffA[2], voffB[2];
#pragma unroll
    for (int i = 0; i < 2; ++i) { int R, C; stage_rc(tid * 16 + i * 8192, R, C); const int Rb = Epi::PERM ? ((R & ~31) + perm32(R & 31)) : R;
        voffA[i] = (unsigned)(R * K + C) * 2u; voffB[i] = (unsigned)(Rb * K + C) * 2u; }
    const size_t kstep = (size_t)(BK * 2);
    const size_t hstep = (size_t)HALF * K * 2;
    const size_t tstep = 2 * hstep;
    const unsigned ldsw = (unsigned)wid * 1024u;
    const int aoff = lds_byte(wr * 64 + fr, fq * 8), boff = lds_byte(wc * 32 + fr, fq * 8);
#define PG8_SA(b, h) (((b) * 2 + (h)) * HTB)
#define PG8_SB(b, h) ((4 + (b) * 2 + (h)) * HTB)
#define PG8_STAGE(bufoff, gbase, voff) do { _Pragma("unroll") for (int _i = 0; _i < 2; ++_i) \
        __builtin_amdgcn_global_load_lds((const unsigned*)((const char*)(gbase) + (voff)[_i]), (PG8_LAS unsigned*)(lds + (bufoff) + ldsw + _i * 8192), 16, 0, 0); } while (0)
#define PG8_LDA(dst, b, h) do { _Pragma("unroll") for (int m = 0; m < 4; ++m) _Pragma("unroll") for (int k = 0; k < 2; ++k) dst[m][k] = *(const PG8_LAS bf16x8*)(lds + PG8_SA(b, h) + aoff + m * 2048 + k * 1024); } while (0)
#define PG8_LDB(dst, b, h) do { _Pragma("unroll") for (int n = 0; n < 2; ++n) _Pragma("unroll") for (int k = 0; k < 2; ++k) dst[n][k] = *(const PG8_LAS bf16x8*)(lds + PG8_SB(b, h) + boff + n * 2048 + k * 1024); } while (0)
#define PG8_MMA(ai, bj, At, Bt) do { __builtin_amdgcn_s_setprio(1); _Pragma("unroll") for (int m = 0; m < 4; ++m) _Pragma("unroll") for (int n = 0; n < 2; ++n) _Pragma("unroll") for (int k = 0; k < 2; ++k) \
        acc[ai][bj][m][n] = __builtin_amdgcn_mfma_f32_16x16x32_bf16(Bt[n][k], At[m][k], acc[ai][bj][m][n], 0, 0, 0); __builtin_amdgcn_s_setprio(0); } while (0)
#define PG8_WAIT_V(n) asm volatile("s_waitcnt vmcnt(" #n ")" ::: "memory")
#define PG8_WAIT_L(n) asm volatile("s_waitcnt lgkmcnt(" #n ")" ::: "memory")
#define PG8_BAR __builtin_amdgcn_s_barrier()
#define PG8_SCHED __builtin_amdgcn_sched_barrier(0)
    Unit cur, nxt; int ui = 0;
    if (!S.next(0, cur)) return;
    f32x4 acc[2][2][4][2];
#pragma unroll
    for (int a = 0; a < 2; ++a)
#pragma unroll
        for (int b = 0; b < 2; ++b)
#pragma unroll
            for (int m = 0; m < 4; ++m)
#pragma unroll
                for (int n = 0; n < 2; ++n) acc[a][b][m][n] = (f32x4){0.f, 0.f, 0.f, 0.f};
    bf16x8 At[4][2], B0[2][2], B1[2][2];
    const char* cA = (const char*)g.A + (size_t)cur.pm * tstep; const char* cB = (const char*)g.Bt + (size_t)cur.pn * tstep;
    S.a_ready(cur);
    if constexpr (SP2) {
        PG8_STAGE(PG8_SB(0, 0), cB, voffB); PG8_STAGE(PG8_SB(0, 1), cB + hstep, voffB); PG8_STAGE(PG8_SA(0, 0), cA, voffA); PG8_STAGE(PG8_SA(0, 1), cA + hstep, voffA);
        if (wr == 1) PG8_BAR;
        PG8_WAIT_V(2); PG8_BAR;
        PG8_STAGE(PG8_SB(1, 0), cB + kstep, voffB); PG8_STAGE(PG8_SA(1, 0), cA + kstep, voffA); PG8_STAGE(PG8_SB(1, 1), cB + hstep + kstep, voffB);
        PG8_WAIT_V(6); PG8_BAR;
    } else {
        PG8_STAGE(PG8_SB(0, 0), cB, voffB); PG8_STAGE(PG8_SA(0, 0), cA, voffA); PG8_STAGE(PG8_SB(0, 1), cB + hstep, voffB); PG8_STAGE(PG8_SA(0, 1), cA + hstep, voffA);
        if (wr == 1) PG8_BAR;
        PG8_WAIT_V(4); PG8_BAR;
        PG8_STAGE(PG8_SB(1, 0), cB + kstep, voffB); PG8_STAGE(PG8_SA(1, 0), cA + kstep, voffA); PG8_STAGE(PG8_SB(1, 1), cB + hstep + kstep, voffB);
        PG8_WAIT_V(6); PG8_BAR;
    }
    for (;;) {
        const bool has_next = S.next(ui + 1, nxt);
        const char* nA = has_next ? (const char*)g.A + (size_t)nxt.pm * tstep : cA; const char* nB = has_next ? (const char*)g.Bt + (size_t)nxt.pn * tstep : cB;
        for (int t = 0; t < nt; t += 2) {
            const bool last = (t == nt - 2);
            const char* a1 = cA + (size_t)(t + 1) * kstep;
            const char* a2 = last ? nA : cA + (size_t)(t + 2) * kstep; const char* b2 = last ? nB : cB + (size_t)(t + 2) * kstep;
            const char* a3 = a2 + kstep; const char* b3 = b2 + kstep;
            if (last && has_next) S.a_ready(nxt);
            if ((E.mode & 4) && t == (nt >> 1)) {
#pragma unroll
                for (int ai = 0; ai < 2; ++ai)
#pragma unroll
                    for (int m = 0; m < 4; ++m) { __builtin_amdgcn_sched_barrier(0); const float rs_ = ((const PG8_LAS float*)(lds + STAGE_BYTES))[ui * 256 + ai * HALF + wr * 64 + m * 16 + fr];
#pragma unroll
                        for (int bj = 0; bj < 2; ++bj)
#pragma unroll
                            for (int n = 0; n < 2; ++n) acc[ai][bj][m][n] = acc[ai][bj][m][n] * rs_; }
            }
            if constexpr (SP2) {
            PG8_LDB(B0, 0, 0); PG8_LDB(B1, 0, 1); PG8_SCHED; PG8_LDA(At, 0, 0); PG8_STAGE(PG8_SA(1, 1), a1 + hstep, voffA);
            PG8_WAIT_V(8); PG8_WAIT_L(0); PG8_BAR; PG8_MMA(0, 0, At, B0); PG8_MMA(0, 1, At, B1); PG8_BAR; PG8_SCHED;
            PG8_LDA(At, 0, 1); PG8_STAGE(PG8_SB(0, 0), b2, voffB); PG8_STAGE(PG8_SB(0, 1), b2 + hstep, voffB); PG8_STAGE(PG8_SA(0, 0), a2, voffA);
            PG8_WAIT_V(8); PG8_WAIT_L(0); PG8_BAR; PG8_MMA(1, 0, At, B0); PG8_MMA(1, 1, At, B1); PG8_BAR; PG8_SCHED;
            PG8_LDB(B0, 1, 0); PG8_LDB(B1, 1, 1); PG8_SCHED; PG8_LDA(At, 1, 0); PG8_STAGE(PG8_SA(0, 1), a2 + hstep, voffA);
            PG8_WAIT_V(8); PG8_WAIT_L(0); PG8_BAR; PG8_MMA(0, 0, At, B0); PG8_MMA(0, 1, At, B1); PG8_BAR; PG8_SCHED;
            PG8_LDA(At, 1, 1); PG8_STAGE(PG8_SB(1, 0), b3, voffB); PG8_STAGE(PG8_SB(1, 1), b3 + hstep, voffB); PG8_STAGE(PG8_SA(1, 0), a3, voffA);
            PG8_WAIT_V(8); PG8_WAIT_L(0); PG8_BAR; PG8_MMA(1, 0, At, B0); PG8_MMA(1, 1, At, B1); PG8_BAR; PG8_SCHED;
            } else {
            PG8_LDB(B0, 0, 0); PG8_SCHED; PG8_LDA(At, 0, 0); PG8_STAGE(PG8_SA(1, 1), a1 + hstep, voffA);
            PG8_WAIT_L(8); PG8_BAR; PG8_WAIT_L(0); PG8_MMA(0, 0, At, B0); PG8_BAR; PG8_SCHED;
            PG8_LDB(B1, 0, 1); PG8_STAGE(PG8_SB(0, 0), b2, voffB);
            PG8_BAR; PG8_WAIT_L(0); PG8_MMA(0, 1, At, B1); PG8_BAR;
            PG8_LDA(At, 0, 1); PG8_STAGE(PG8_SA(0, 0), a2, voffA);
            PG8_BAR; PG8_WAIT_L(0); PG8_MMA(1, 0, At, B0); PG8_BAR; PG8_SCHED;
            PG8_STAGE(PG8_SB(0, 1), b2 + hstep, voffB);
            PG8_WAIT_V(6); PG8_BAR; PG8_MMA(1, 1, At, B1); PG8_BAR;
            PG8_LDB(B0, 1, 0); PG8_SCHED; PG8_LDA(At, 1, 0); PG8_STAGE(PG8_SA(0, 1), a2 + hstep, voffA);
            PG8_WAIT_L(8); PG8_BAR; PG8_WAIT_L(0); PG8_MMA(0, 0, At, B0); PG8_BAR; PG8_SCHED;
            PG8_LDB(B1, 1, 1); PG8_STAGE(PG8_SB(1, 0), b3, voffB);
            PG8_BAR; PG8_WAIT_L(0); PG8_MMA(0, 1, At, B1); PG8_BAR;
            PG8_LDA(At, 1, 1); PG8_STAGE(PG8_SA(1, 0), a3, voffA);
            PG8_BAR; PG8_WAIT_L(0); PG8_MMA(1, 0, At, B0); PG8_BAR; PG8_SCHED;
            PG8_STAGE(PG8_SB(1, 1), b3 + hstep, voffB);
            PG8_WAIT_V(6); PG8_BAR; PG8_MMA(1, 1, At, B1); PG8_BAR;
            }
        }
        if constexpr (ALIGN_EPI) { if (wr == 0) PG8_BAR; }
        if constexpr (!Epi::AFTER_DRAIN) { E(acc, cur, wr, wc, fr, fq); S.done(cur); }
        if (!has_next) break;
#pragma unroll
        for (int a = 0; a < 2; ++a)
#pragma unroll
            for (int b = 0; b < 2; ++b)
#pragma unroll
                for (int m = 0; m < 4; ++m)
#pragma unroll
                    for (int n = 0; n < 2; ++n) acc[a][b][m][n] = (f32x4){0.f, 0.f, 0.f, 0.f};
        cur = nxt; cA = nA; cB = nB; ++ui;
        if constexpr (ALIGN_EPI) { if (wr == 1) PG8_BAR; }
    }
    PG8_WAIT_V(0);
    if constexpr (!ALIGN_EPI) { if (wr == 0) PG8_BAR; }
    PG8_BAR;
    if constexpr (Epi::AFTER_DRAIN) { E.fused(acc, cur, wr, wc, fr, fq, lds, wid, lane); S.done(cur); }
#undef PG8_SA
#undef PG8_SB
#undef PG8_STAGE
#undef PG8_LDA
#undef PG8_LDB
#undef PG8_MMA
#undef PG8_WAIT_V
#undef PG8_WAIT_L
#undef PG8_BAR
#undef PG8_SCHED
}
}

#define LAS __attribute__((address_space(3)))
typedef unsigned short bf16;
typedef short bf16x8 __attribute__((ext_vector_type(8)));
typedef float f32x4 __attribute__((ext_vector_type(4)));
typedef unsigned u32x4 __attribute__((ext_vector_type(4)));
typedef unsigned u32x2 __attribute__((ext_vector_type(2)));

constexpr int D = 1024, NB = 16, SEQ = 4096, DEPTH = 4, DBT = 8, DSQ = 16;
constexpr int MP = NB * SEQ, MS = DBT * DSQ, MV = MP + MS, MT = 65792;
constexpr int NIN = 2560, INDIM = 2568, DFF = 4096, NSEQ = 24, PW = 2560;
constexpr float RMS_EPS = 1e-6f, LN_EPS = 1e-5f;
constexpr int NTHR = 512, LDS_BYTES = 159744;
#ifndef REP_MIX
#define REP_MIX 1
#endif
#ifndef REP_SSD
#define REP_SSD 1
#endif
#ifndef REP_CMLP
#define REP_CMLP 1
#endif
#ifndef REP_CONV
#define REP_CONV 1
#endif
#ifndef REP_SYNC
#define REP_SYNC 1
#endif
#define GSYNC() do { for (int rs_ = 0; rs_ < REP_SYNC; ++rs_) gbar(gb, tid); } while (0)
#ifndef REP_NORM
#define REP_NORM 1
#endif
#ifndef REP_GEMM
#define REP_GEMM 1
#endif
#ifndef REP_PREP
#define REP_PREP 1
#endif
#ifndef REP_FIN
#define REP_FIN 1
#endif

constexpr size_t O_YP = 0, O_YS = 67108864, O_CP = 67239936, O_SP = 67436544, O_CS = 71630848, O_SS = 71729152, O_VS = 73826304;
constexpr size_t WS_WIN = 0;
constexpr size_t WS_WOUT = WS_WIN + (size_t)DEPTH * NIN * D * 2;
constexpr size_t WS_WFF1 = WS_WOUT + (size_t)DEPTH * D * D * 2;
constexpr size_t WS_WFF2 = WS_WFF1 + (size_t)DEPTH * DFF * D * 2;
constexpr size_t WS_WS = WS_WFF2 + (size_t)DEPTH * DFF * D * 2;
constexpr size_t WS_WDT = WS_WS + (size_t)DEPTH * 4 * 128 * 128 * 2;
constexpr size_t WS_MOD = WS_WDT + (size_t)DEPTH * 8 * 1024 * 4;
constexpr size_t WS_DT = WS_MOD + (size_t)DEPTH * NSEQ * 6144 * 4;
constexpr size_t WS_SSQ = WS_DT + (size_t)MT * 8 * 4;
constexpr size_t WS_H = 104857600;
constexpr size_t WS_MF = WS_H + (size_t)MT * D * 2;
constexpr size_t WS_BIG = WS_MF + (size_t)MT * D * 2;
constexpr size_t WS_XB = WS_BIG + (size_t)MT * DFF * 2;
constexpr size_t WS_SSQ2 = WS_XB + (size_t)MT * D * 2;
constexpr size_t WS_END = WS_SSQ2 + (size_t)MT * 16 * 4;
static_assert(WS_SSQ + (size_t)MT * 8 * 4 <= WS_H, "ws map");
static_assert(WS_END <= (size_t)1073741824, "ws map end");

struct Args { const float* in[23]; float* out; unsigned char* ws; };

__device__ __forceinline__ unsigned pk2(float lo, float hi) { return pg8::cvt_pk_bf16(lo, hi); }
__device__ __forceinline__ float bflo(unsigned u) { return __uint_as_float(u << 16); }
__device__ __forceinline__ float bfhi(unsigned u) { return __uint_as_float(u & 0xffff0000u); }
__device__ __forceinline__ float bf2f(unsigned short b) { return __uint_as_float(((unsigned)b) << 16); }
__device__ __forceinline__ float wave_sum(float v) {
#pragma unroll
    for (int o = 1; o < 64; o <<= 1) v += __shfl_xor(v, o);
    return v;
}
__device__ __forceinline__ float silu_f(float x) { return x * __builtin_amdgcn_rcpf(1.0f + __builtin_amdgcn_exp2f(-1.4426950409f * x)); }
__device__ __forceinline__ int hide(int v) { asm volatile("" : "+v"(v)); return v; }
#define DPP_STEP(v, ctrl, rmask) do { const int t_ = __builtin_amdgcn_update_dpp(0, __float_as_int(v), (ctrl), (rmask), 0xf, false); v += __int_as_float(t_); } while (0)
__device__ __forceinline__ float wave_scan_incl(float v) {
    DPP_STEP(v, 0x111, 0xf); DPP_STEP(v, 0x112, 0xf); DPP_STEP(v, 0x114, 0xf); DPP_STEP(v, 0x118, 0xf);
    DPP_STEP(v, 0x142, 0xa); DPP_STEP(v, 0x143, 0xc);
    return v;
}
__device__ __forceinline__ f32x4 mfma16(bf16x8 a, bf16x8 b, f32x4 c) { return __builtin_amdgcn_mfma_f32_16x16x32_bf16(a, b, c, 0, 0, 0); }

struct GBar { unsigned* w; unsigned gen, xcc, nloc, nx; };
__device__ __forceinline__ unsigned gb_ld(unsigned* p) { return __hip_atomic_load(p, __ATOMIC_RELAXED, __HIP_MEMORY_SCOPE_AGENT); }
__device__ __forceinline__ void gbar(GBar& b, int tid) {
    __syncthreads();
    if (tid == 0) {
        __builtin_amdgcn_fence(__ATOMIC_RELEASE, "agent");
        const unsigned g1 = b.gen + 1u;
        const unsigned old = __hip_atomic_fetch_add(b.w + 64 * b.xcc, 1u, __ATOMIC_RELAXED, __HIP_MEMORY_SCOPE_AGENT);
        if (old + 1u == g1 * b.nloc) {
            __builtin_amdgcn_fence(__ATOMIC_ACQ_REL, "agent");
            const unsigned ot = __hip_atomic_fetch_add(b.w + 512, 1u, __ATOMIC_RELAXED, __HIP_MEMORY_SCOPE_AGENT);
            if (ot + 1u == g1 * b.nx) {
                __builtin_amdgcn_fence(__ATOMIC_ACQ_REL, "agent");
#pragma unroll
                for (int j = 0; j < 8; ++j) __hip_atomic_store(b.w + 576 + 64 * j, g1, __ATOMIC_RELAXED, __HIP_MEMORY_SCOPE_AGENT);
            }
        }
        while (gb_ld(b.w + 576 + 64 * b.xcc) < g1) __builtin_amdgcn_s_sleep(1);
        __builtin_amdgcn_fence(__ATOMIC_ACQUIRE, "agent");
    }
    __syncthreads();
    ++b.gen;
}

__device__ __forceinline__ void transpose_item(const float* W, int Nsrc, int K, bf16* WT, LAS float* scr, int kb, int nb, int shift_from, int lane, const float* kscale) {
    const int k0 = 64 * kb, n0 = 32 * nb, sn0 = n0 + (n0 >= shift_from ? 8 : 0);
#pragma unroll 8
    for (int i = 0; i < 32; ++i) { const int kk = 2 * i + (lane >> 5); float wv = W[(size_t)(k0 + kk) * Nsrc + sn0 + (lane & 31)]; if (kscale != nullptr && k0 + kk < 512) wv *= kscale[k0 + kk]; scr[kk * 33 + (lane & 31)] = wv; }
    asm volatile("s_waitcnt lgkmcnt(0)" ::: "memory");
    const int c = lane & 7;
#pragma unroll
    for (int j = 0; j < 4; ++j) { const int n = (lane >> 3) + 8 * j; const LAS float* s = scr + (8 * c) * 33 + n;
        u32x4 o; o.x = pk2(s[0 * 33], s[1 * 33]); o.y = pk2(s[2 * 33], s[3 * 33]); o.z = pk2(s[4 * 33], s[5 * 33]); o.w = pk2(s[6 * 33], s[7 * 33]);
        *(u32x4*)(WT + (size_t)(n0 + n) * K + k0 + 8 * c) = o; }
    asm volatile("s_waitcnt lgkmcnt(0)" ::: "memory");
}

__device__ __forceinline__ void prep_transposes(LAS unsigned char* L, const Args& a, int lo, int hi, int gw, int NGW, int lane, int wave) {
    unsigned char* ws = a.ws;
    LAS float* scr = (LAS float*)(L + wave * 8448);
    constexpr int I_IN = 16 * 80, I_OUT = 16 * 32, I_F1 = 16 * 128, I_F2 = 64 * 32, I_L = I_IN + I_OUT + I_F1 + I_F2;
    for (int it = lo * I_L + gw; it < hi * I_L; it += NGW) {
        const int l = it / I_L; int r = it - l * I_L;
        if (r < I_IN) { transpose_item(a.in[9] + (size_t)l * D * INDIM, INDIM, D, (bf16*)(ws + WS_WIN) + (size_t)l * NIN * D, scr, r / 80, r % 80, 1536, lane, nullptr); continue; }
        r -= I_IN;
        if (r < I_OUT) { transpose_item(a.in[20] + (size_t)l * D * D, D, D, (bf16*)(ws + WS_WOUT) + (size_t)l * D * D, scr, r / 32, r % 32, 1 << 30, lane, a.in[15] + l * 512); continue; }
        r -= I_OUT;
        if (r < I_F1) { transpose_item(a.in[21] + (size_t)l * D * DFF, DFF, D, (bf16*)(ws + WS_WFF1) + (size_t)l * DFF * D, scr, r / 128, r % 128, 1 << 30, lane, nullptr); continue; }
        r -= I_F1;
        transpose_item(a.in[22] + (size_t)l * DFF * D, D, DFF, (bf16*)(ws + WS_WFF2) + (size_t)l * D * DFF, scr, r / 32, r % 32, 1 << 30, lane, nullptr);
    }
}

__device__ __forceinline__ void prep_phase(LAS unsigned char* L, const Args& a, int bid, int G, int tid) {
    const int lane = tid & 63, wave = tid >> 6;
    unsigned char* ws = a.ws;
    prep_transposes(L, a, 0, 1, bid * 8 + wave, G * 8, lane, wave);
    {
        const int gt = bid * NTHR + tid, NGT = G * NTHR;
        const float* w_s = a.in[18]; bf16* WS = (bf16*)(ws + WS_WS);
        for (int i = gt; i < DEPTH * 4 * 128 * 128; i += NGT) { const int jj = i & 127, ii = (i >> 7) & 127; WS[i] = (bf16)(pk2(jj <= ii ? w_s[i] : 0.f, 0.f) & 0xffffu); }
        float* WDT = (float*)(ws + WS_WDT);
        for (int i = gt; i < DEPTH * 8 * 1024; i += NGT) { const int k = i & 1023, hd = (i >> 10) & 7, l = i >> 13; WDT[i] = a.in[9][((size_t)l * D + k) * INDIM + 1536 + hd]; }
    }
    __syncthreads();
    {
        LAS float* SC = (LAS float*)L;
        LAS float* RED = (LAS float*)(L + 98304);
        for (int i = tid; i < NSEQ * 1024; i += NTHR) { const int s = i >> 10, k = i & 1023; const float c = s < 16 ? a.in[4][s * 1024 + k] : a.in[5][(s - 16) * 1024 + k]; SC[k * 24 + s] = silu_f(c); }
        __syncthreads();
        float* MOD = (float*)(ws + WS_MOD);
        for (int u = bid; u < DEPTH * 96; u += G) {
            const int l = u / 96, n0 = (u % 96) * 64;
            const float* wm = a.in[6] + (size_t)l * D * 6144 + n0 + lane;
            float acc[24];
#pragma unroll
            for (int s = 0; s < 24; ++s) acc[s] = 0.f;
            for (int kb = 0; kb < 4; ++kb) {
                float wv[32];
#pragma unroll
                for (int i = 0; i < 32; ++i) wv[i] = wm[(size_t)(wave * 128 + kb * 32 + i) * 6144];
#pragma unroll
                for (int i = 0; i < 32; ++i) { const int k = wave * 128 + kb * 32 + i;
#pragma unroll
                    for (int s4 = 0; s4 < 6; ++s4) { const f32x4 c4 = *(const LAS f32x4*)(SC + k * 24 + 4 * s4);
                        acc[4 * s4 + 0] += c4.x * wv[i]; acc[4 * s4 + 1] += c4.y * wv[i]; acc[4 * s4 + 2] += c4.z * wv[i]; acc[4 * s4 + 3] += c4.w * wv[i]; } }
            }
#pragma unroll
            for (int s = 0; s < 24; ++s) RED[(wave * 24 + s) * 64 + lane] = acc[s];
            __syncthreads();
            for (int o = tid; o < 1536; o += NTHR) { const int s = o >> 6, col = o & 63; float v = a.in[7][l * 6144 + n0 + col];
#pragma unroll
                for (int w = 0; w < 8; ++w) v += RED[(w * 24 + s) * 64 + col];
                MOD[((size_t)l * NSEQ + s) * 6144 + n0 + col] = v; }
            __syncthreads();
        }
    }
}

struct NormCfg {
    const float* xsrc_p; const float* xsrc_s; float* xdst_p; float* xdst_s; const bf16* xb_src; bf16* xb_dst;
    const bf16* mf; const float* gate; const float* ngpost;
    const float* ngpre; const float* sc; const float* sh; bf16* H;
    const float* wdt; const float* dtbias; float* DT;
};
template <int CTRL> __device__ __forceinline__ float dppf(float v) { return __int_as_float(__builtin_amdgcn_update_dpp(0, __float_as_int(v), CTRL, 0xf, 0xf, false)); }
__device__ __forceinline__ float sx1(float v) { return dppf<0xB1>(v); }
__device__ __forceinline__ float sx2(float v) { return dppf<0x4E>(v); }
__device__ __forceinline__ float sx4(float v) { return dppf<0x1B>(dppf<0x141>(v)); }
__device__ __forceinline__ float sx8(float v) { return dppf<0x128>(v); }
__device__ __forceinline__ float add_x16(float v) { const unsigned u = __float_as_uint(v); const auto r = __builtin_amdgcn_permlane16_swap(u, u, false, false); return __uint_as_float(r[0]) + __uint_as_float(r[1]); }
__device__ __forceinline__ float add_x32(float v) { const unsigned u = __float_as_uint(v); const auto r = __builtin_amdgcn_permlane32_swap(u, u, false, false); return __uint_as_float(r[0]) + __uint_as_float(r[1]); }
__device__ __forceinline__ void reduce4(const float (&s)[4], int lane, float (&tot)[4]) {
    const bool b0 = lane & 1, b1 = lane & 2;
    const float e0 = (b0 ? s[2] : s[0]) + sx1(b0 ? s[0] : s[2]);
    const float e1 = (b0 ? s[3] : s[1]) + sx1(b0 ? s[1] : s[3]);
    float f = (b1 ? e1 : e0) + sx2(b1 ? e0 : e1);
    f += sx4(f); f += sx8(f); f = add_x16(f); f = add_x32(f);
    tot[0] = __builtin_amdgcn_readlane(f, 0); tot[1] = __builtin_amdgcn_readlane(f, 2); tot[2] = __builtin_amdgcn_readlane(f, 1); tot[3] = __builtin_amdgcn_readlane(f, 3);
}
__device__ __forceinline__ float reduce8(const float (&d)[8], int lane) {
    const bool b0 = lane & 1, b1 = lane & 2, b2 = lane & 4;
    float e[4], f[2];
#pragma unroll
    for (int k = 0; k < 4; ++k) e[k] = (b0 ? d[4 + k] : d[k]) + sx1(b0 ? d[k] : d[4 + k]);
#pragma unroll
    for (int k = 0; k < 2; ++k) f[k] = (b1 ? e[2 + k] : e[k]) + sx2(b1 ? e[k] : e[2 + k]);
    float g = (b2 ? f[1] : f[0]) + sx4(b2 ? f[0] : f[1]);
    g += sx8(g); g = add_x16(g); g = add_x32(g);
    return g;
}
__device__ __forceinline__ void reduce2(const float (&s)[2], int lane, float (&tot)[2]) {
    const bool b0 = lane & 1;
    float f = (b0 ? s[1] : s[0]) + __shfl_xor(b0 ? s[0] : s[1], 1);
    f += __shfl_xor(f, 2); f += __shfl_xor(f, 4); f += __shfl_xor(f, 8); f += __shfl_xor(f, 16); f += __shfl_xor(f, 32);
    tot[0] = __builtin_amdgcn_readlane(f, 0); tot[1] = __builtin_amdgcn_readlane(f, 1);
}
#define NCOL(q) (512 * ((q) >> 1) + 8 * lane + 4 * ((q) & 1))
__device__ __forceinline__ void norm_pass(LAS unsigned char* L, const NormCfg c, int bid, int G, int tid) {
    const int lane = tid & 63, wave = tid >> 6;
    const bool has_post = c.mf != nullptr, has_pre = c.ngpre != nullptr, has_dt = c.wdt != nullptr;
    if (has_dt) {
        for (int i = tid; i < 2048; i += NTHR) ((LAS f32x4*)L)[i] = ((const f32x4*)c.wdt)[i];
        __syncthreads();
    }
    const int gw = bid * 8 + wave, NGW = G * 8;
    for (int sl = gw; sl < MV / 32; sl += NGW) {
        for (int it = 0; it < 8; ++it) {
            const int rbase = sl * 32 + it * 4;
            const bool isp = rbase < MP; const int seq = isp ? (rbase >> 12) : (16 + ((rbase - MP) >> 4));
            const size_t xoff = (isp ? (size_t)rbase * D : (size_t)(rbase - MP) * D);
            const float* xs = (isp ? c.xsrc_p : c.xsrc_s) + xoff;
            const unsigned voff = (unsigned)seq * 6144u;
            f32x4 x[4][4];
            if (c.xb_src != nullptr) {
                const bf16* xb = c.xb_src + (size_t)rbase * D + 8 * lane;
#pragma unroll
                for (int rr = 0; rr < 4; ++rr)
#pragma unroll
                    for (int Q = 0; Q < 2; ++Q) { const u32x4 t4 = __builtin_nontemporal_load((const u32x4*)(xb + rr * D + 512 * Q));
                        x[rr][2 * Q] = (f32x4){bflo(t4.x), bfhi(t4.x), bflo(t4.y), bfhi(t4.y)}; x[rr][2 * Q + 1] = (f32x4){bflo(t4.z), bfhi(t4.z), bflo(t4.w), bfhi(t4.w)}; }
            } else {
#pragma unroll
                for (int rr = 0; rr < 4; ++rr)
#pragma unroll
                    for (int q = 0; q < 4; ++q) x[rr][q] = __builtin_nontemporal_load((const f32x4*)(xs + rr * D + NCOL(q)));
            }
            if (has_post) {
                const bf16* mr = c.mf + (size_t)rbase * D + 8 * lane;
                u32x4 mm[4][2];
#pragma unroll
                for (int rr = 0; rr < 4; ++rr)
#pragma unroll
                    for (int Q = 0; Q < 2; ++Q) mm[rr][Q] = __builtin_nontemporal_load((const u32x4*)(mr + rr * D + 512 * Q));
                float ss[4], tot[4];
#pragma unroll
                for (int rr = 0; rr < 4; ++rr) { float a = 0.f;
#pragma unroll
                    for (int Q = 0; Q < 2; ++Q) { const u32x4 t = mm[rr][Q]; const float m0 = bflo(t.x), m1 = bfhi(t.x), m2 = bflo(t.y), m3 = bfhi(t.y), m4 = bflo(t.z), m5 = bfhi(t.z), m6 = bflo(t.w), m7 = bfhi(t.w);
                        a += ((m0 * m0 + m1 * m1) + (m2 * m2 + m3 * m3)) + ((m4 * m4 + m5 * m5) + (m6 * m6 + m7 * m7)); }
                    ss[rr] = a; }
                reduce4(ss, lane, tot);
#pragma unroll
                for (int rr = 0; rr < 4; ++rr) tot[rr] = rsqrtf(tot[rr] * (1.0f / D) + RMS_EPS);
                float* xd = (isp ? c.xdst_p : c.xdst_s) + xoff; bf16* xbd = c.xb_dst + (size_t)rbase * D + 8 * lane; const bool st_bf = c.xb_dst != nullptr;
#pragma unroll
                for (int Q = 0; Q < 2; ++Q) {
                    const f32x4 gn0 = *(const f32x4*)(c.gate + voff + NCOL(2 * Q)) * *(const f32x4*)(c.ngpost + NCOL(2 * Q));
                    const f32x4 gn1 = *(const f32x4*)(c.gate + voff + NCOL(2 * Q + 1)) * *(const f32x4*)(c.ngpost + NCOL(2 * Q + 1));
#pragma unroll
                    for (int rr = 0; rr < 4; ++rr) { const u32x4 t = mm[rr][Q];
                        x[rr][2 * Q] = x[rr][2 * Q] + gn0 * ((f32x4){bflo(t.x), bfhi(t.x), bflo(t.y), bfhi(t.y)} * tot[rr]);
                        x[rr][2 * Q + 1] = x[rr][2 * Q + 1] + gn1 * ((f32x4){bflo(t.z), bfhi(t.z), bflo(t.w), bfhi(t.w)} * tot[rr]);
                        if (st_bf) { u32x4 o; o.x = pk2(x[rr][2 * Q].x, x[rr][2 * Q].y); o.y = pk2(x[rr][2 * Q].z, x[rr][2 * Q].w); o.z = pk2(x[rr][2 * Q + 1].x, x[rr][2 * Q + 1].y); o.w = pk2(x[rr][2 * Q + 1].z, x[rr][2 * Q + 1].w);
                            __builtin_nontemporal_store(o, (u32x4*)(xbd + rr * D + 512 * Q)); }
                        else { __builtin_nontemporal_store(x[rr][2 * Q], (f32x4*)(xd + rr * D + NCOL(2 * Q))); __builtin_nontemporal_store(x[rr][2 * Q + 1], (f32x4*)(xd + rr * D + NCOL(2 * Q + 1))); } } }
            }
            if (has_pre) {
                float ss[4], tot[4];
#pragma unroll
                for (int rr = 0; rr < 4; ++rr) { float a = 0.f;
#pragma unroll
                    for (int q = 0; q < 4; ++q) a += (x[rr][q].x * x[rr][q].x + x[rr][q].y * x[rr][q].y) + (x[rr][q].z * x[rr][q].z + x[rr][q].w * x[rr][q].w);
                    ss[rr] = a; }
                reduce4(ss, lane, tot);
#pragma unroll
                for (int rr = 0; rr < 4; ++rr) tot[rr] = rsqrtf(tot[rr] * (1.0f / D) + RMS_EPS);
                bf16* hr = c.H + (size_t)rbase * D + 8 * lane;
#pragma unroll
                for (int Q = 0; Q < 2; ++Q) {
                    const f32x4 ns0 = *(const f32x4*)(c.ngpre + NCOL(2 * Q)) * (*(const f32x4*)(c.sc + voff + NCOL(2 * Q)) + 1.0f), sh0 = *(const f32x4*)(c.sh + voff + NCOL(2 * Q));
                    const f32x4 ns1 = *(const f32x4*)(c.ngpre + NCOL(2 * Q + 1)) * (*(const f32x4*)(c.sc + voff + NCOL(2 * Q + 1)) + 1.0f), sh1 = *(const f32x4*)(c.sh + voff + NCOL(2 * Q + 1));
#pragma unroll
                    for (int rr = 0; rr < 4; ++rr) { x[rr][2 * Q] = (x[rr][2 * Q] * tot[rr]) * ns0 + sh0; x[rr][2 * Q + 1] = (x[rr][2 * Q + 1] * tot[rr]) * ns1 + sh1;
                        u32x4 o; o.x = pk2(x[rr][2 * Q].x, x[rr][2 * Q].y); o.y = pk2(x[rr][2 * Q].z, x[rr][2 * Q].w); o.z = pk2(x[rr][2 * Q + 1].x, x[rr][2 * Q + 1].y); o.w = pk2(x[rr][2 * Q + 1].z, x[rr][2 * Q + 1].w);
                        *(u32x4*)(hr + rr * D + 512 * Q) = o; } }
                if (has_dt) {
                    const int hd_l = ((lane & 1) << 2) | (lane & 2) | ((lane >> 2) & 1);
                    const float db = c.dtbias[hd_l];
#pragma unroll
                    for (int rp = 0; rp < 2; ++rp) {
                        float d[2][8];
#pragma unroll
                        for (int hd = 0; hd < 8; ++hd) { float a0 = 0.f, a1 = 0.f;
#pragma unroll
                            for (int q = 0; q < 4; ++q) { const f32x4 w4 = *(const LAS f32x4*)(L + (size_t)(hd * 1024 + NCOL(q)) * 4);
                                const f32x4 xa = x[2 * rp][q], xb = x[2 * rp + 1][q];
                                a0 += (xa.x * w4.x + xa.y * w4.y) + (xa.z * w4.z + xa.w * w4.w); a1 += (xb.x * w4.x + xb.y * w4.y) + (xb.z * w4.z + xb.w * w4.w); }
                            d[0][hd] = a0; d[1][hd] = a1; }
#pragma unroll
                        for (int r2 = 0; r2 < 2; ++r2) { const float gsum = reduce8(d[r2], lane);
                            if (lane < 8) { const float v = gsum + db; c.DT[(size_t)(rbase + 2 * rp + r2) * 8 + hd_l] = v > 20.f ? v : log1pf(expf(v)); } }
                    }
                }
            }
        }
    }
    if (has_dt) __syncthreads();
}

struct MixCtx {
    const bf16* P; bf16* Y; const float* DT; const bf16* WS; bf16* XC; float* SSQ2;
    const float* state_conv; const float* state_ssd; const float* conv_w; const float* conv_b; const float* a_log; const float* d_skip;
    const float* v_ln_g; const float* v_ln_b; const float* b_s; float* out;
};
__device__ __forceinline__ void conv_unit(const MixCtx& X, int l, int s, int c, bool smp, int tid) {
    const int nvalid = smp ? 16 : 64, row0 = smp ? MP + s * DSQ : s * SEQ + c * 64;
    const int ch = 2 * tid;
    const bf16* Pc = X.P + (size_t)row0 * PW + 512 + ch;
    unsigned raw[67];
#pragma unroll
    for (int i = 0; i < 3; ++i) { unsigned v = 0u;
        if (smp) { const float* sp = X.state_conv + ((size_t)(l * DBT + s) * 3 + i) * 1024 + ch; v = pk2(sp[0], sp[1]); }
        else if (c > 0) v = *(const unsigned*)(Pc + (i - 3) * PW);
        raw[i] = v; }
#pragma unroll
    for (int t = 0; t < 64; ++t) raw[3 + t] = (t < nvalid) ? __builtin_nontemporal_load((const unsigned*)(Pc + t * PW)) : 0u;
    float w[4][2], bia[2];
#pragma unroll
    for (int k = 0; k < 4; ++k) { const float2 w2 = *(const float2*)(X.conv_w + (l * 4 + k) * 1024 + ch); w[k][0] = w2.x; w[k][1] = w2.y; }
    { const float2 b2 = *(const float2*)(X.conv_b + l * 1024 + ch); bia[0] = b2.x; bia[1] = b2.y; }
    bf16* xo = X.XC + (size_t)row0 * 1024 + ch;
#pragma unroll
    for (int t = 0; t < 64; ++t) { float v0 = bia[0], v1 = bia[1];
#pragma unroll
        for (int k = 0; k < 4; ++k) { v0 += w[k][0] * bflo(raw[t + k]); v1 += w[k][1] * bfhi(raw[t + k]); }
        if (t < nvalid) *(unsigned*)(xo + (size_t)t * 1024) = pk2(silu_f(v0), silu_f(v1)); }
    if (smp || c == 63) {
        float* co = X.out + (smp ? O_CS : O_CP) + (size_t)(l * (smp ? DBT : NB) + s) * 3 * 1024 + ch;
        const unsigned r0 = smp ? raw[3 + 13] : raw[3 + 61], r1 = smp ? raw[3 + 14] : raw[3 + 62], r2 = smp ? raw[3 + 15] : raw[3 + 63];
        *(float2*)(co) = make_float2(bflo(r0), bfhi(r0)); *(float2*)(co + 1024) = make_float2(bflo(r1), bfhi(r1)); *(float2*)(co + 2048) = make_float2(bflo(r2), bfhi(r2));
    }
}

constexpr int SL_XT = 0, SL_XWT = 9216, SL_LM = 18432, SL_BN = 27648, SL_CN = 45056, SL_HB = 62464, SL_BT = 79872, SL_YS = 98304, SL_SC = 115712;

#define SSD_LOAD_RAW(cc) do { \
    const char* Pb_ = (const char*)(X.XC + (size_t)(row0 + (cc) * 64) * 1024); \
    _Pragma("unroll") for (int i_ = 0; i_ < 4; ++i_) { const int t_ = min(4 * sx + i_, nvalid - 1); rawx[i_] = *(const unsigned*)(Pb_ + (unsigned)((t_ * 1024 + chx) * 2)); } \
    _Pragma("unroll") for (int i_ = 0; i_ < 8; ++i_) { const int t_ = min(8 * sb + i_, nvalid - 1); rawb[i_] = *(const unsigned*)(Pb_ + (unsigned)((t_ * 1024 + chb) * 2)); rawc[i_] = *(const unsigned*)(Pb_ + (unsigned)((t_ * 1024 + chc) * 2)); } \
} while (0)

__device__ __forceinline__ void ssd_unit(LAS unsigned char* L, const MixCtx& X, int l, int b, int h, bool smp, int tid) {
    const int lane = tid & 63, wave = tid >> 6, fr = lane & 15, fq = lane >> 4;
    const int g = h >> 2;
    const int nch = smp ? 1 : 64, nvalid = smp ? 16 : 64, row0 = smp ? MP + b * DSQ : b * SEQ;
    const float A_h = -expf(X.a_log[l * 8 + h]), dsk = X.d_skip[l * 8 + h];
    const int cx = tid & 31, sx = tid >> 5, cb = tid & 63, sb = tid >> 6;
    const int chx = h * 64 + 2 * cx, chb = 512 + g * 128 + 2 * cb, chc = 768 + g * 128 + 2 * cb;
    LAS bf16* XT = (LAS bf16*)(L + SL_XT); LAS bf16* XWT = (LAS bf16*)(L + SL_XWT); LAS bf16* LM = (LAS bf16*)(L + SL_LM);
    LAS bf16* BN = (LAS bf16*)(L + SL_BN); LAS bf16* CN = (LAS bf16*)(L + SL_CN); LAS bf16* HB = (LAS bf16*)(L + SL_HB);
    LAS bf16* BT = (LAS bf16*)(L + SL_BT); LAS float* YS = (LAS float*)(L + SL_YS); LAS float* SCa = (LAS float*)(L + SL_SC); LAS float* SCd = SCa + 64;
    const int tp_s = wave >> 1, tn0 = (wave & 1) * 4, ti = wave >> 1, t2 = (wave & 1) * 2;
    const size_t sbase = smp ? (((size_t)(l * DBT + b) * 8 + h) * 64) * 128 : 0;
    f32x4 hacc[4];
#pragma unroll
    for (int a = 0; a < 4; ++a)
#pragma unroll
        for (int r = 0; r < 4; ++r) { const int p = 16 * tp_s + 4 * fq + r, n = 16 * (tn0 + a) + fr;
            const float v = smp ? X.state_ssd[sbase + (size_t)p * 128 + n] : 0.f; hacc[a][r] = v; HB[p * 136 + n] = (bf16)(pk2(v, 0.f) & 0xffffu); }
    unsigned rawx[4], rawb[8], rawc[8];
    SSD_LOAD_RAW(0);
    float dtv; { const float d0_ = X.DT[(size_t)(row0 + min(lane, nvalid - 1)) * 8 + h]; dtv = (lane < nvalid) ? d0_ : 0.f; }
    __syncthreads();
    for (int c = 0; c < nch; ++c) {
        const int zi = tid >> 3, zp0 = (tid & 7) * 8;
        const u32x4 zreg = *(const u32x4*)(X.P + (size_t)(row0 + c * 64 + min(zi, nvalid - 1)) * PW + h * 64 + zp0);
        const float acum = wave_scan_incl(dtv * A_h);
        const float a_last = __int_as_float(__builtin_amdgcn_readlane(__float_as_int(acum), 63));
        const float wend = __expf(a_last - acum) * dtv;
        if (wave == 0) { SCa[lane] = acum; SCd[lane] = dtv; }
        {
            float x0[4], x1[4], w0[4], w1[4];
#pragma unroll
            for (int jj = 0; jj < 4; ++jj) { const int t = 4 * sx + jj; float v0 = bflo(rawx[jj]), v1 = bfhi(rawx[jj]); if (t >= nvalid) { v0 = 0.f; v1 = 0.f; }
                const int wv_ = __builtin_amdgcn_readfirstlane(tid >> 6);
                const float we_lo = __int_as_float(__builtin_amdgcn_readlane(__float_as_int(wend), 8 * wv_ + jj)), we_hi = __int_as_float(__builtin_amdgcn_readlane(__float_as_int(wend), 8 * wv_ + 4 + jj));
                const float we = (lane & 32) ? we_hi : we_lo;
                x0[jj] = v0; x1[jj] = v1; w0[jj] = v0 * we; w1[jj] = v1 * we; }
            u32x2 o;
            o.x = pk2(x0[0], x0[1]); o.y = pk2(x0[2], x0[3]); *(LAS u32x2*)(XT + (2 * cx) * 72 + 4 * sx) = o;
            o.x = pk2(x1[0], x1[1]); o.y = pk2(x1[2], x1[3]); *(LAS u32x2*)(XT + (2 * cx + 1) * 72 + 4 * sx) = o;
            o.x = pk2(w0[0], w0[1]); o.y = pk2(w0[2], w0[3]); *(LAS u32x2*)(XWT + (2 * cx) * 72 + 4 * sx) = o;
            o.x = pk2(w1[0], w1[1]); o.y = pk2(w1[2], w1[3]); *(LAS u32x2*)(XWT + (2 * cx + 1) * 72 + 4 * sx) = o;
        }
        {
#pragma unroll
            for (int jj = 0; jj < 8; ++jj) { const int t = 8 * sb + jj; if (t >= nvalid) { rawb[jj] = 0u; rawc[jj] = 0u; }
                *(LAS unsigned*)(BN + t * 136 + 2 * cb) = rawb[jj];
                *(LAS unsigned*)(CN + t * 136 + 2 * cb) = rawc[jj]; }
            u32x4 o;
            o.x = (rawb[0] & 0xffffu) | (rawb[1] << 16); o.y = (rawb[2] & 0xffffu) | (rawb[3] << 16); o.z = (rawb[4] & 0xffffu) | (rawb[5] << 16); o.w = (rawb[6] & 0xffffu) | (rawb[7] << 16); *(LAS u32x4*)(BT + (2 * cb) * 72 + 8 * sb) = o;
            o.x = (rawb[0] >> 16) | (rawb[1] & 0xffff0000u); o.y = (rawb[2] >> 16) | (rawb[3] & 0xffff0000u); o.z = (rawb[4] >> 16) | (rawb[5] & 0xffff0000u); o.w = (rawb[6] >> 16) | (rawb[7] & 0xffff0000u); *(LAS u32x4*)(BT + (2 * cb + 1) * 72 + 8 * sb) = o;
        }
        __syncthreads();
        { const int cn = min(c + 1, nch - 1); SSD_LOAD_RAW(cn); const float dn_ = X.DT[(size_t)(row0 + cn * 64 + min(lane, nvalid - 1)) * 8 + h]; dtv = (lane < nvalid) ? dn_ : 0.f; }
        f32x4 cbacc[2], yoff[2];
#pragma unroll
        for (int e = 0; e < 2; ++e) { cbacc[e] = (f32x4){0.f, 0.f, 0.f, 0.f}; yoff[e] = (f32x4){0.f, 0.f, 0.f, 0.f}; }
#pragma unroll
        for (int kk = 0; kk < 4; ++kk) {
            const bf16x8 af = *(const LAS bf16x8*)(CN + (16 * ti + fr) * 136 + 32 * kk + 8 * fq);
#pragma unroll
            for (int e = 0; e < 2; ++e) {
                const bf16x8 bf_ = *(const LAS bf16x8*)(BN + (16 * (t2 + e) + fr) * 136 + 32 * kk + 8 * fq);
                const bf16x8 hf = *(const LAS bf16x8*)(HB + (16 * (t2 + e) + fr) * 136 + 32 * kk + 8 * fq);
                cbacc[e] = mfma16(af, bf_, cbacc[e]); yoff[e] = mfma16(af, hf, yoff[e]); }
        }
        float ai4[4];
#pragma unroll
        for (int r = 0; r < 4; ++r) ai4[r] = SCa[16 * ti + 4 * fq + r];
#pragma unroll
        for (int e = 0; e < 2; ++e) { const int j = 16 * (t2 + e) + fr; const float aj = SCa[j], dj = SCd[j];
#pragma unroll
            for (int r = 0; r < 4; ++r) { const int i = 16 * ti + 4 * fq + r;
                const float val = (i >= j) ? cbacc[e][r] * __expf(fminf(ai4[r] - aj, 0.f)) * dj : 0.f;
                LM[i * 72 + j] = (bf16)(pk2(val, 0.f) & 0xffffu); } }
        __syncthreads();
        f32x4 yd[2];
#pragma unroll
        for (int e = 0; e < 2; ++e) yd[e] = (f32x4){0.f, 0.f, 0.f, 0.f};
#pragma unroll
        for (int kk = 0; kk < 2; ++kk) {
            const bf16x8 af = *(const LAS bf16x8*)(LM + (16 * ti + fr) * 72 + 32 * kk + 8 * fq);
#pragma unroll
            for (int e = 0; e < 2; ++e) { const bf16x8 xf = *(const LAS bf16x8*)(XT + (16 * (t2 + e) + fr) * 72 + 32 * kk + 8 * fq); yd[e] = mfma16(af, xf, yd[e]); }
        }
#pragma unroll
        for (int e = 0; e < 2; ++e) { const int p = 16 * (t2 + e) + fr; const u32x2 xx = *(const LAS u32x2*)(XT + p * 72 + 16 * ti + 4 * fq);
            const float xv[4] = {bflo(xx.x), bfhi(xx.x), bflo(xx.y), bfhi(xx.y)};
#pragma unroll
            for (int r = 0; r < 4; ++r) { const int i = 16 * ti + 4 * fq + r; YS[i * 68 + p] = yd[e][r] + __expf(ai4[r]) * yoff[e][r] + dsk * xv[r]; } }
        {
            const float ea = __expf(SCa[63]);
#pragma unroll
            for (int a = 0; a < 4; ++a) hacc[a] = hacc[a] * ea;
#pragma unroll
            for (int kk = 0; kk < 2; ++kk) {
                const bf16x8 af = *(const LAS bf16x8*)(XWT + (16 * tp_s + fr) * 72 + 32 * kk + 8 * fq);
#pragma unroll
                for (int a = 0; a < 4; ++a) { const bf16x8 bf_ = *(const LAS bf16x8*)(BT + (16 * (tn0 + a) + fr) * 72 + 32 * kk + 8 * fq); hacc[a] = mfma16(af, bf_, hacc[a]); }
            }
#pragma unroll
            for (int a = 0; a < 4; ++a)
#pragma unroll
                for (int r = 0; r < 4; ++r) { const int p = 16 * tp_s + 4 * fq + r, n = 16 * (tn0 + a) + fr; HB[p * 136 + n] = (bf16)(pk2(hacc[a][r], 0.f) & 0xffffu); }
        }
        __syncthreads();
        {
            const f32x4 ya = *(const LAS f32x4*)(YS + zi * 68 + zp0), yb = *(const LAS f32x4*)(YS + zi * 68 + zp0 + 4);
            float yg[8];
            yg[0] = ya.x * bflo(zreg.x); yg[1] = ya.y * bfhi(zreg.x); yg[2] = ya.z * bflo(zreg.y); yg[3] = ya.w * bfhi(zreg.y);
            yg[4] = yb.x * bflo(zreg.z); yg[5] = yb.y * bfhi(zreg.z); yg[6] = yb.z * bflo(zreg.w); yg[7] = yb.w * bfhi(zreg.w);
            float ss = 0.f;
#pragma unroll
            for (int e = 0; e < 8; ++e) ss += yg[e] * yg[e];
            ss += __int_as_float(__builtin_amdgcn_update_dpp(0, __float_as_int(ss), 0xB1, 0xf, 0xf, false));
            ss += __int_as_float(__builtin_amdgcn_update_dpp(0, __float_as_int(ss), 0x4E, 0xf, 0xf, false));
            ss += __int_as_float(__builtin_amdgcn_update_dpp(0, __float_as_int(ss), 0x141, 0xf, 0xf, false));
            if (zi < nvalid) { const size_t row = (size_t)(row0 + c * 64 + zi);
                u32x4 o; o.x = pk2(yg[0], yg[1]); o.y = pk2(yg[2], yg[3]); o.z = pk2(yg[4], yg[5]); o.w = pk2(yg[6], yg[7]);
                *(u32x4*)(X.Y + row * D + h * 64 + zp0) = o;
                if ((tid & 7) < 2) X.SSQ2[row * 16 + h * 2 + (tid & 7)] = (tid & 7) == 0 ? ss : 0.f; }
        }
    }
    {
        float* so = X.out + (smp ? O_SS : O_SP) + (((size_t)(l * (smp ? DBT : NB) + b) * 8 + h) * 64) * 128;
#pragma unroll
        for (int a = 0; a < 4; ++a)
#pragma unroll
            for (int r = 0; r < 4; ++r) { const int p = 16 * tp_s + 4 * fq + r, n = 16 * (tn0 + a) + fr; so[(size_t)p * 128 + n] = hacc[a][r]; }
    }
    __syncthreads();
}

__device__ __forceinline__ void cmlp_unit(LAS unsigned char* L, const MixCtx& X, int l, int b, int kc, bool smp, int tid) {
    const int lane = tid & 63, wave = tid >> 6, fr = lane & 15, fq = lane >> 4;
    const int r0 = smp ? MP + b * DSQ : b * SEQ + kc * 128, Q = smp ? 16 : 128;
    LAS bf16* VT = (LAS bf16*)L;
    LAS bf16* STG = (LAS bf16*)(L + 139264) + wave * 1024;
    u32x4 vraw[16];
#pragma unroll
    for (int t = 0; t < 16; ++t) { const int j = 16 * wave + t; vraw[t] = (j < Q) ? *(const u32x4*)(X.P + (size_t)(r0 + j) * PW + 2048 + 8 * lane) : (u32x4){0u, 0u, 0u, 0u}; }
    float mean16[16], rstd16[16];
#pragma unroll
    for (int t4 = 0; t4 < 4; ++t4) {
        float s4[4], tot[4];
#pragma unroll
        for (int k = 0; k < 4; ++k) { const u32x4 r = vraw[4 * t4 + k]; s4[k] = ((bflo(r.x) + bfhi(r.x)) + (bflo(r.y) + bfhi(r.y))) + ((bflo(r.z) + bfhi(r.z)) + (bflo(r.w) + bfhi(r.w))); }
        reduce4(s4, lane, tot);
#pragma unroll
        for (int k = 0; k < 4; ++k) { const float m = tot[k] * (1.0f / 512.f); mean16[4 * t4 + k] = m; const u32x4 r = vraw[4 * t4 + k];
            const float d0 = bflo(r.x) - m, d1 = bfhi(r.x) - m, d2 = bflo(r.y) - m, d3 = bfhi(r.y) - m, d4 = bflo(r.z) - m, d5 = bfhi(r.z) - m, d6 = bflo(r.w) - m, d7 = bfhi(r.w) - m;
            s4[k] = ((d0 * d0 + d1 * d1) + (d2 * d2 + d3 * d3)) + ((d4 * d4 + d5 * d5) + (d6 * d6 + d7 * d7)); }
        reduce4(s4, lane, tot);
#pragma unroll
        for (int k = 0; k < 4; ++k) rstd16[4 * t4 + k] = rsqrtf(tot[k] * (1.0f / 512.f) + LN_EPS);
    }
    {
        const f32x4 g0 = *(const f32x4*)(X.v_ln_g + l * 512 + 8 * lane), g1 = *(const f32x4*)(X.v_ln_g + l * 512 + 8 * lane + 4);
        const f32x4 b0 = *(const f32x4*)(X.v_ln_b + l * 512 + 8 * lane), b1 = *(const f32x4*)(X.v_ln_b + l * 512 + 8 * lane + 4);
#pragma unroll
        for (int pr = 0; pr < 8; ++pr) {
#pragma unroll
            for (int hh = 0; hh < 2; ++hh) { const int t = 2 * pr + hh; const u32x4 r = vraw[t]; const float m = mean16[t], rs = rstd16[t];
                const f32x4 ya = (f32x4){(bflo(r.x) - m) * rs, (bfhi(r.x) - m) * rs, (bflo(r.y) - m) * rs, (bfhi(r.y) - m) * rs} * g0 + b0;
                const f32x4 yb = (f32x4){(bflo(r.z) - m) * rs, (bfhi(r.z) - m) * rs, (bflo(r.w) - m) * rs, (bfhi(r.w) - m) * rs} * g1 + b1;
                u32x4 o; o.x = pk2(ya.x, ya.y); o.y = pk2(ya.z, ya.w); o.z = pk2(yb.x, yb.y); o.w = pk2(yb.z, yb.w);
                *(LAS u32x4*)(STG + hh * 512 + 8 * lane) = o;
                if (smp && 16 * wave + t < Q) { float* vo = X.out + O_VS + ((size_t)(l * DBT + b) * DSQ + 16 * wave + t) * 512 + 8 * lane; *(f32x4*)vo = ya; *(f32x4*)(vo + 4) = yb; } }
            const int j0 = 16 * wave + 2 * pr;
#pragma unroll
            for (int e = 0; e < 8; ++e) { const int d = lane + 64 * e; const unsigned lo = STG[d], hi = STG[512 + d]; *(LAS unsigned*)(VT + d * 136 + j0) = lo | (hi << 16); }
        }
    }
    __syncthreads();
    const int g = wave >> 1, dt0 = (wave & 1) * 4;
    const bf16* wsg = X.WS + (size_t)(l * 4 + g) * 128 * 128;
    bf16x8 bw[20];
    {
        int idx = 0;
#pragma unroll
        for (int it2 = 0; it2 < 4; ++it2)
#pragma unroll
            for (int kk = 0; kk < 4; ++kk)
                if (kk <= it2) {
#pragma unroll
                    for (int e = 0; e < 2; ++e) { bw[idx] = *(const bf16x8*)(wsg + (size_t)(16 * (2 * it2 + e) + fr) * 128 + 32 * kk + 8 * fq); ++idx; } }
    }
    int bidx = 0;
#pragma unroll
    for (int it2 = 0; it2 < 4; ++it2) {
        if (smp && it2 > 0) break;
        u32x2 uu[4][2];
#pragma unroll
        for (int e = 0; e < 2; ++e) { const int i = min(16 * (2 * it2 + e) + fr, Q - 1);
#pragma unroll
            for (int a = 0; a < 4; ++a) uu[a][e] = *(const u32x2*)(X.P + (size_t)(r0 + i) * PW + 1536 + g * 128 + (dt0 + a) * 16 + 4 * fq); }
        f32x4 acc[4][2];
#pragma unroll
        for (int a = 0; a < 4; ++a)
#pragma unroll
            for (int e = 0; e < 2; ++e) acc[a][e] = (f32x4){0.f, 0.f, 0.f, 0.f};
#pragma unroll
        for (int kk = 0; kk < 4; ++kk) {
            if (kk <= it2) {
#pragma unroll
                for (int a = 0; a < 4; ++a) { const bf16x8 af = *(const LAS bf16x8*)(VT + (g * 128 + (dt0 + a) * 16 + fr) * 136 + 32 * kk + 8 * fq);
#pragma unroll
                    for (int e = 0; e < 2; ++e) acc[a][e] = mfma16(af, bw[bidx + e], acc[a][e]); }
                bidx += 2;
            }
        }
#pragma unroll
        for (int e = 0; e < 2; ++e) { const int i = 16 * (2 * it2 + e) + fr;
            if (i < Q) { const float bs = X.b_s[(l * 4 + g) * 128 + i];
#pragma unroll
                for (int a = 0; a < 4; ++a) { const int d = g * 128 + (dt0 + a) * 16 + 4 * fq; const u32x2 uv = uu[a][e];
                    u32x2 o; o.x = pk2(bflo(uv.x) * (acc[a][e][0] + bs), bfhi(uv.x) * (acc[a][e][1] + bs)); o.y = pk2(bflo(uv.y) * (acc[a][e][2] + bs), bfhi(uv.y) * (acc[a][e][3] + bs));
                    *(u32x2*)(X.Y + (size_t)(r0 + i) * D + 512 + d) = o; } } }
    }
    __syncthreads();
}

__device__ __forceinline__ void ssd_finalize(bf16* Y, const bf16* P, const float* gw_, int bid, int G, int tid) {
    const int lane = tid & 63, wave = tid >> 6;
    const f32x4 ga = *(const f32x4*)(gw_ + 8 * lane), gb = *(const f32x4*)(gw_ + 8 * lane + 4);
    for (int sl = bid * 8 + wave; sl < MV / 32; sl += G * 8) {
        for (int it = 0; it < 8; ++it) {
            const int rbase = sl * 32 + it * 4;
            bf16* yp = Y + (size_t)rbase * D + 8 * lane; const bf16* zp = P + (size_t)rbase * PW + 8 * lane;
            u32x4 yy[4], zz[4];
#pragma unroll
            for (int rr = 0; rr < 4; ++rr) { yy[rr] = __builtin_nontemporal_load((const u32x4*)(yp + rr * D)); zz[rr] = __builtin_nontemporal_load((const u32x4*)(zp + rr * PW)); }
            float v[4][8], ss[4], tot[4];
#pragma unroll
            for (int rr = 0; rr < 4; ++rr) {
                v[rr][0] = bflo(yy[rr].x) * silu_f(bflo(zz[rr].x)); v[rr][1] = bfhi(yy[rr].x) * silu_f(bfhi(zz[rr].x)); v[rr][2] = bflo(yy[rr].y) * silu_f(bflo(zz[rr].y)); v[rr][3] = bfhi(yy[rr].y) * silu_f(bfhi(zz[rr].y));
                v[rr][4] = bflo(yy[rr].z) * silu_f(bflo(zz[rr].z)); v[rr][5] = bfhi(yy[rr].z) * silu_f(bfhi(zz[rr].z)); v[rr][6] = bflo(yy[rr].w) * silu_f(bflo(zz[rr].w)); v[rr][7] = bfhi(yy[rr].w) * silu_f(bfhi(zz[rr].w));
                float a = 0.f;
#pragma unroll
                for (int e = 0; e < 8; ++e) a += v[rr][e] * v[rr][e];
                ss[rr] = a; }
            reduce4(ss, lane, tot);
#pragma unroll
            for (int rr = 0; rr < 4; ++rr) { const float rstd = rsqrtf(tot[rr] * (1.0f / 512.f) + RMS_EPS);
                u32x4 o; o.x = pk2(v[rr][0] * rstd * ga.x, v[rr][1] * rstd * ga.y); o.y = pk2(v[rr][2] * rstd * ga.z, v[rr][3] * rstd * ga.w);
                o.z = pk2(v[rr][4] * rstd * gb.x, v[rr][5] * rstd * gb.y); o.w = pk2(v[rr][6] * rstd * gb.z, v[rr][7] * rstd * gb.w);
                *(u32x4*)(yp + rr * D) = o; }
        }
    }
}

__device__ __forceinline__ f32x4 skinny_tile(const bf16* ap, const bf16* bp, int nkk = 32) {
    f32x4 acc = (f32x4){0.f, 0.f, 0.f, 0.f};
#pragma unroll 16
    for (int kk = 0; kk < nkk; ++kk) acc = mfma16(*(const bf16x8*)(bp + 32 * kk), *(const bf16x8*)(ap + 32 * kk), acc);
    return acc;
}
__device__ __forceinline__ void skinny_store(bf16* O, int N, int mt, int nt, int fr, int fq, int mode, f32x4 v) {
    const int act = (mode == 2) ? 2 : ((mode == 1 && (nt >> 4) >= 6) ? 1 : ((mode == 1 && (nt >> 4) < 2) ? 3 : 0));
    if (act == 1) {
#pragma unroll
        for (int j = 0; j < 4; ++j) v[j] = pg8::gelu_tanh_f(v[j]); }
    else if (act == 2) {
#pragma unroll
        for (int j = 0; j < 4; ++j) { const float a0 = fmaxf(v[j], 0.f); v[j] = a0 * a0; } }
    else if (act == 3) {
#pragma unroll
        for (int j = 0; j < 4; ++j) v[j] = silu_f(v[j]); }
    u32x2 o; o.x = pk2(v[0], v[1]); o.y = pk2(v[2], v[3]);
    *(u32x2*)(O + (size_t)(MP + 16 * mt + fr) * N + 16 * nt + 4 * fq) = o;
}
__device__ __forceinline__ void skinny_gemm(LAS unsigned char* L, const bf16* A, const bf16* Bt, int N, int K, bf16* O, int mode, const float* ssq, int bid, int G, int tid) {
    const int lane = tid & 63, wave = tid >> 6, fr = lane & 15, fq = lane >> 4;
    const int tiles = 8 * (N >> 4);
    if (K == 1024) {
        for (int t = bid * 8 + wave; t < tiles; t += G * 8) { const int mt = t & 7, nt = t >> 3;
            const bf16* ap = A + (size_t)(MP + 16 * mt + fr) * K + 8 * fq; const bf16* bp = Bt + (size_t)(16 * nt + fr) * K + 8 * fq;
            f32x4 acc;
            if (ssq != nullptr) {
                const float* sp = ssq + (size_t)(MP + 16 * mt + fr) * 16; const f32x4 s0 = *(const f32x4*)sp, s1 = *(const f32x4*)(sp + 4), s2 = *(const f32x4*)(sp + 8), s3 = *(const f32x4*)(sp + 12);
                const float tot = (((s0.x + s0.y) + (s0.z + s0.w)) + ((s1.x + s1.y) + (s1.z + s1.w))) + (((s2.x + s2.y) + (s2.z + s2.w)) + ((s3.x + s3.y) + (s3.z + s3.w)));
                acc = skinny_tile(ap, bp, 16) * rsqrtf(tot * (1.0f / 512.f) + RMS_EPS) + skinny_tile(ap + 512, bp + 512, 16);
            } else acc = skinny_tile(ap, bp);
            skinny_store(O, N, mt, nt, fr, fq, mode, acc); }
    } else {
        LAS f32x4* red = (LAS f32x4*)L;
        for (int tp = bid; tp * 2 < tiles; tp += G) { const int t = tp * 2 + (wave >> 2), ks = wave & 3, mt = t & 7, nt = t >> 3;
            const f32x4 acc = skinny_tile(A + (size_t)(MP + 16 * mt + fr) * K + ks * 1024 + 8 * fq, Bt + (size_t)(16 * nt + fr) * K + ks * 1024 + 8 * fq);
            red[wave * 64 + lane] = acc;
            __syncthreads();
            if (ks == 0) { const f32x4 v = (red[wave * 64 + lane] + red[(wave + 1) * 64 + lane]) + (red[(wave + 2) * 64 + lane] + red[(wave + 3) * 64 + lane]); skinny_store(O, N, mt, nt, fr, fq, mode, v); }
            __syncthreads(); }
    }
}

__global__ void __launch_bounds__(NTHR, 2) mega_fwd(Args a) {
    extern __shared__ __attribute__((aligned(16))) unsigned char lds_raw[];
    LAS unsigned char* L = (LAS unsigned char*)lds_raw;
    cg::grid_group grid = cg::this_grid();
    const int tid = threadIdx.x, bid = blockIdx.x, G = gridDim.x;
    unsigned char* ws = a.ws;
    bf16* Hb = (bf16*)(ws + WS_H); bf16* MF = (bf16*)(ws + WS_MF); bf16* BIG = (bf16*)(ws + WS_BIG);
    float* MOD = (float*)(ws + WS_MOD); float* DTb = (float*)(ws + WS_DT); bf16* XB = (bf16*)(ws + WS_XB);
    float* outp = a.out + O_YP; float* outs = a.out + O_YS;
    const float* norm_g = a.in[8];

    GBar gb; gb.w = (unsigned*)(ws + WS_SSQ); gb.gen = 0u; gb.xcc = (unsigned)__builtin_amdgcn_s_getreg((3 << 11) | 20) & 7u;
    if (tid == 0) __hip_atomic_fetch_add(gb.w + 1088 + 64 * gb.xcc, 1u, __ATOMIC_RELAXED, __HIP_MEMORY_SCOPE_AGENT);
    for (int rep = 0; rep < REP_PREP; ++rep) prep_phase(L, a, bid, G, hide(tid));
    grid.sync();
    { unsigned nx = 0u; gb.nloc = gb_ld(gb.w + 1088 + 64 * gb.xcc);
#pragma unroll
      for (int j = 0; j < 8; ++j) nx += gb_ld(gb.w + 1088 + 64 * j) != 0u ? 1u : 0u;
      gb.nx = nx; }

    for (int step = 0; step <= 4 * DEPTH; ++step) {
        const int l = step >> 2, st = step & 3;
        if (st == 0 || st == 2) {
            NormCfg c;
            if (st == 0) {
                if (l > 0) { const int lp = l - 1; c.mf = MF; c.gate = MOD + (size_t)lp * NSEQ * 6144 + 5 * 1024; c.ngpost = norm_g + (lp * 4 + 3) * 1024; c.xsrc_p = outp; c.xsrc_s = outs; c.xdst_p = outp; c.xdst_s = outs;
                    c.xb_src = XB; c.xb_dst = (l < DEPTH) ? XB : nullptr; }
                else { c.mf = nullptr; c.gate = nullptr; c.ngpost = nullptr; c.xsrc_p = a.in[0]; c.xsrc_s = a.in[1]; c.xdst_p = nullptr; c.xdst_s = nullptr; c.xb_src = nullptr; c.xb_dst = nullptr; }
                if (l < DEPTH) { c.ngpre = norm_g + (l * 4 + 0) * 1024; c.sc = MOD + (size_t)l * NSEQ * 6144 + 1 * 1024; c.sh = MOD + (size_t)l * NSEQ * 6144; c.H = Hb;
                    c.wdt = (const float*)(ws + WS_WDT) + (size_t)l * 8192; c.dtbias = a.in[12] + l * 8; c.DT = DTb; }
                else { c.ngpre = nullptr; c.sc = nullptr; c.sh = nullptr; c.H = nullptr; c.wdt = nullptr; c.dtbias = nullptr; c.DT = nullptr; }
            } else {
                c.mf = MF; c.gate = MOD + (size_t)l * NSEQ * 6144 + 2 * 1024; c.ngpost = norm_g + (l * 4 + 1) * 1024;
                c.xsrc_p = a.in[0]; c.xsrc_s = a.in[1]; c.xdst_p = outp; c.xdst_s = outs; c.xb_src = (l == 0) ? nullptr : XB; c.xb_dst = XB;
                c.ngpre = norm_g + (l * 4 + 2) * 1024; c.sc = MOD + (size_t)l * NSEQ * 6144 + 4 * 1024; c.sh = MOD + (size_t)l * NSEQ * 6144 + 3 * 1024; c.H = Hb;
                c.wdt = nullptr; c.dtbias = nullptr; c.DT = nullptr;
            }
            for (int rn = 0; rn < REP_NORM; ++rn) {
                NormCfg c2 = c; if (rn + 1 < REP_NORM) {
                    if (c2.xb_dst != nullptr) c2.xb_dst = BIG + (size_t)2 * MT * D; else { c2.xdst_p = (float*)BIG; c2.xdst_s = (float*)BIG + (size_t)MP * D; }
                    if (c2.H != nullptr) c2.H = BIG; if (c2.DT != nullptr) c2.DT = (float*)(BIG + (size_t)3 * MT * D); }
                if (c2.mf != nullptr || c2.ngpre != nullptr) norm_pass(L, c2, bid, G, hide(tid));
                if (rn + 1 < REP_NORM) GSYNC();
            }
            GSYNC();
        }
        if (step == 4 * DEPTH) break;
        if (st == 1) {
            MixCtx X; X.P = BIG; X.Y = Hb; X.DT = DTb; X.WS = (const bf16*)(ws + WS_WS); X.XC = MF; X.SSQ2 = (float*)(ws + WS_SSQ2);
            X.state_conv = a.in[2]; X.state_ssd = a.in[3]; X.conv_w = a.in[10]; X.conv_b = a.in[11]; X.a_log = a.in[13]; X.d_skip = a.in[14];
            X.v_ln_g = a.in[16]; X.v_ln_b = a.in[17]; X.b_s = a.in[19]; X.out = a.out;
            for (int rep = 0; rep < REP_CONV; ++rep)
            for (int u = bid; u < 1024 + 8; u += G) { const bool smp = u >= 1024; conv_unit(X, l, smp ? u - 1024 : (u >> 6), smp ? 0 : (u & 63), smp, hide(tid)); }
            GSYNC();
            {
                const int nj = G - 128;
                const int u0 = bid, ulim = bid < 128 ? 128 : 128 + 64 + 8 + 512, ustr = bid < 128 ? (1 << 20) : nj;
                for (int rep = 0; rep < REP_MIX; ++rep)
                for (int u = u0; u < ulim; u += ustr) {
                    if (u < 192) { const bool smp = u >= 128; const int v = u & 127;
                        const int cb_ = smp ? ((v >> 3) & 7) : ((v & 7) * 2 + (v >> 6)), ch_ = smp ? (v & 7) : ((v >> 3) & 7);
                        for (int r2 = 0; r2 < REP_SSD; ++r2) ssd_unit(L, X, l, cb_, ch_, smp, hide(tid)); }
                    else { const int v = u - 200; const bool smp = v < 0; for (int r2 = 0; r2 < REP_CMLP; ++r2) cmlp_unit(L, X, l, smp ? (u - 192) : (v >> 5), smp ? 0 : (v & 31), smp, hide(tid)); }
                }
            }
            if (bid >= 128 && l + 1 < DEPTH) { const int t2_ = hide(tid); prep_transposes(L, a, l + 1, l + 2, (bid - 128) * 8 + (t2_ >> 6), (G - 128) * 8, t2_ & 63, t2_ >> 6); }
            GSYNC();
        }
        {
            const bf16* A; const bf16* Bt; int N, K, mode; bf16* O;
            if (st == 0) { A = Hb; Bt = (const bf16*)(ws + WS_WIN) + (size_t)l * NIN * D; N = NIN; K = D; O = BIG; mode = 1; }
            else if (st == 1) { A = Hb; Bt = (const bf16*)(ws + WS_WOUT) + (size_t)l * D * D; N = D; K = D; O = MF; mode = 0; }
            else if (st == 2) { A = Hb; Bt = (const bf16*)(ws + WS_WFF1) + (size_t)l * DFF * D; N = DFF; K = D; O = BIG; mode = 2; }
            else { A = BIG; Bt = (const bf16*)(ws + WS_WFF2) + (size_t)l * D * DFF; N = D; K = DFF; O = MF; mode = 0; }
            pg8::Gemm gm{A, Bt, MP, N, K}; pg8::StaticOrder S; S.init(MP, N, G, bid);
            const float* ssq2 = (st == 1) ? (const float*)(ws + WS_SSQ2) : nullptr;
            LAS float* rtab = (LAS float*)(L + 131072);
            if (st == 1) {
                pg8::Unit uu;
                for (int i = 0; i < 8 && S.next(i, uu); ++i)
                    if (tid < 256) { const int tq = hide(tid); const float* sp = ssq2 + (size_t)(uu.pm * 256 + tq) * 16; const f32x4 s0 = *(const f32x4*)sp, s1 = *(const f32x4*)(sp + 4), s2 = *(const f32x4*)(sp + 8), s3 = *(const f32x4*)(sp + 12);
                        const float tot = (((s0.x + s0.y) + (s0.z + s0.w)) + ((s1.x + s1.y) + (s1.z + s1.w))) + (((s2.x + s2.y) + (s2.z + s2.w)) + ((s3.x + s3.y) + (s3.z + s3.w)));
                        rtab[i * 256 + tq] = rsqrtf(tot * (1.0f / 512.f) + RMS_EPS); }
                __syncthreads();
            }
            pg8::EpiAct E{O, N, mode | ((st == 1) ? 4 : 0), 6};
            for (int rep = 0; rep < REP_GEMM; ++rep) { pg8::gemm_phase<pg8::EpiAct, pg8::StaticOrder, true, true>(L, gm, S, E); skinny_gemm(L, A, Bt, N, K, O, mode, ssq2, bid, G, hide(tid)); }
            GSYNC();
        }
    }
}

extern "C" void kernel_launch(void* const* d_in, const int* in_sizes, int n_in, void* d_out, int out_size, void* d_ws, size_t ws_size, hipStream_t stream) {
    static int ready = 0;
    if (!ready) {
        if (n_in != 23 || ws_size < WS_END) { fprintf(stderr, "kernel_launch: unexpected n_in %d / ws_size %zu (need %zu)\n", n_in, ws_size, (size_t)WS_END); }
        if (hipFuncSetAttribute((const void*)mega_fwd, hipFuncAttributeMaxDynamicSharedMemorySize, LDS_BYTES) != hipSuccess) fprintf(stderr, "kernel_launch: hipFuncSetAttribute failed\n");
        int per_cu = 0;
        if (hipOccupancyMaxActiveBlocksPerMultiprocessor(&per_cu, (const void*)mega_fwd, NTHR, LDS_BYTES) != hipSuccess || per_cu < 1) fprintf(stderr, "kernel_launch: occupancy query says %d\n", per_cu);
        (void)hipGetLastError();
        ready = 1;
    }
    (void)hipMemsetAsync((unsigned char*)d_ws + WS_SSQ, 0, 8192, stream);
    Args a{};
    for (int i = 0; i < 23; ++i) a.in[i] = (const float*)d_in[i];
    a.out = (float*)d_out; a.ws = (unsigned char*)d_ws;
    void* args[] = {&a};
    hipError_t e = hipLaunchCooperativeKernel((const void*)mega_fwd, dim3(256), dim3(NTHR), args, LDS_BYTES, stream);
    if (e != hipSuccess) fprintf(stderr, "kernel_launch: cooperative launch failed: %s\n", hipGetErrorString(e));
}
```

```cpp
#include <hip/hip_runtime.h>
#include <hip/hip_cooperative_groups.h>
#include <cstdio>
#include <cstdint>
namespace cg = cooperative_groups;
namespace pg8 {
#define PG8_LAS __attribute__((address_space(3)))
typedef unsigned short bf16_t;
typedef short bf16x8 __attribute__((ext_vector_type(8)));
typedef float f32x4 __attribute__((ext_vector_type(4)));
typedef unsigned u32x4 __attribute__((ext_vector_type(4)));
constexpr int BM = 256, BK = 64, HALF = 128, HTB = HALF * BK * 2  , STAGE_BYTES = 8 * HTB, NXCD = 8, WGM = 8;

__host__ __device__ __forceinline__ int lds_byte(int r, int c) { const int st = (r >> 4) * 2 + (c >> 5), rr = r & 15, cc = c & 31, ob = rr * 64 + cc * 2; return st * 1024 + (ob ^ (((ob >> 9) & 1) << 5)); }
__host__ __device__ __forceinline__ void stage_rc(int b, int& R, int& C) { const int st = b / 1024, sb = b % 1024, swz = sb ^ (((sb >> 9) & 1) << 5); R = (st >> 1) * 16 + swz / 64; C = (st & 1) * 32 + (swz % 64) / 2; }
__host__ __device__ __forceinline__ int perm32(int rho) { const int n = rho >> 4, i = rho & 15; return 8 * (i >> 2) + 4 * n + (i & 3); }

struct Unit { int pm, pn; };
struct Gemm { const bf16_t* A; const bf16_t* Bt; int M, N, K; };

struct StaticOrder {
    int nM, nN, nwg, G, c;
    __host__ __device__ void init(int M, int N, int G_, int c_) { nM = M / BM; nN = N / BM; nwg = nM * nN; G = G_; c = c_; }
    __host__ __device__ bool next(int i, Unit& u) const {
        const long L = (long)i * G + c; if (L >= nwg) return false;
        int wgid = (int)L; { const int q = nwg / NXCD, r = nwg % NXCD, xcd = wgid % NXCD, off = wgid / NXCD; wgid = (xcd < r ? xcd * (q + 1) : r * (q + 1) + (xcd - r) * q) + off; }
        const int nig = WGM * nN, gid = wgid / nig, fm = gid * WGM, gsz = (nM - fm) < WGM ? (nM - fm) : WGM;
        u.pm = fm + ((wgid % nig) % gsz); u.pn = (wgid % nig) / gsz; return true;
    }
    __device__ __forceinline__ void a_ready(const Unit&) const {}
    __device__ __forceinline__ void done(const Unit&) const {}
};

__device__ __forceinline__ unsigned cvt_pk_bf16(float lo, float hi) { unsigned r; asm volatile("v_cvt_pk_bf16_f32 %0, %1, %2" : "=v"(r) : "v"(lo), "v"(hi)); return r; }
__device__ __forceinline__ float gelu_tanh_f(float x) {
    const float t = x * (1.5957691216f + 0.0713548163f * x * x);
    return x * __builtin_amdgcn_rcpf(1.0f + __builtin_amdgcn_exp2f(-1.4426950409f * t));
}
struct EpiAct {
    static constexpr bool PERM = true, AFTER_DRAIN = false;
    bf16_t* O; int ldc; int mode; int act_pn;
    __device__ __forceinline__ void operator()(const f32x4 (&acc)[2][2][4][2], const Unit& u, int wr, int wc, int fr, int fq) const {
        const int row0 = u.pm * BM + wr * 64 + fr; const int col0 = u.pn * BM + wc * 32 + 8 * fq;
        const int act = ((mode & 3) == 2) ? 2 : (((mode & 3) == 1 && u.pn >= act_pn) ? 1 : (((mode & 3) == 1 && u.pn < 2) ? 3 : 0));
#pragma unroll
        for (int ai = 0; ai < 2; ++ai)
#pragma unroll
            for (int m = 0; m < 4; ++m) { bf16_t* rowp = O + (size_t)(row0 + ai * HALF + m * 16) * ldc + col0;
#pragma unroll
                for (int bj = 0; bj < 2; ++bj) { f32x4 v0 = acc[ai][bj][m][0], v1 = acc[ai][bj][m][1];
                    if (act == 1) {
#pragma unroll
                        for (int j = 0; j < 4; ++j) { v0[j] = gelu_tanh_f(v0[j]); v1[j] = gelu_tanh_f(v1[j]); } }
                    else if (act == 2) {
#pragma unroll
                        for (int j = 0; j < 4; ++j) { const float a0 = fmaxf(v0[j], 0.f), a1 = fmaxf(v1[j], 0.f); v0[j] = a0 * a0; v1[j] = a1 * a1; } }
                    else if (act == 3) {
#pragma unroll
                        for (int j = 0; j < 4; ++j) { v0[j] = v0[j] * __builtin_amdgcn_rcpf(1.0f + __builtin_amdgcn_exp2f(-1.4426950409f * v0[j])); v1[j] = v1[j] * __builtin_amdgcn_rcpf(1.0f + __builtin_amdgcn_exp2f(-1.4426950409f * v1[j])); } }
                    u32x4 w; w.x = cvt_pk_bf16(v0[0], v0[1]); w.y = cvt_pk_bf16(v0[2], v0[3]); w.z = cvt_pk_bf16(v1[0], v1[1]); w.w = cvt_pk_bf16(v1[2], v1[3]);
                    if ((mode & 3) != 2) __builtin_nontemporal_store(w, (u32x4*)(rowp + bj * HALF)); else *(u32x4*)(rowp + bj * HALF) = w; } }
    }
};

template <class Epi, class Sched, bool ALIGN_EPI = false, bool SP2 = false>
__device__ __forceinline__ void gemm_phase(PG8_LAS unsigned char* lds, const Gemm g, const Sched& S, const Epi& E) {
    int tid_ = threadIdx.x; asm volatile("" : "+v"(tid_));
    const int tid = tid_, wid = __builtin_amdgcn_readfirstlane(tid >> 6), lane = tid & 63, wr = wid >> 2, wc = wid & 3, fr = lane & 15, fq = lane >> 4;
    const int K = g.K, nt = K / BK;
    unsigned voffA[2], voffB[2];
#pragma unroll
    for (int i = 0; i < 2; ++i) { int R, C; stage_rc(tid * 16 + i * 8192, R, C); const int Rb = Epi::PERM ? ((R & ~31) + perm32(R & 31)) : R;
        voffA[i] = (unsigned)(R * K + C) * 2u; voffB[i] = (unsigned)(Rb * K + C) * 2u; }
    const size_t kstep = (size_t)(BK * 2);
    const size_t hstep = (size_t)HALF * K * 2;
    const size_t tstep = 2 * hstep;
    const unsigned ldsw = (unsigned)wid * 1024u;
    const int aoff = lds_byte(wr * 64 + fr, fq * 8), boff = lds_byte(wc * 32 + fr, fq * 8);
#define PG8_SA(b, h) (((b) * 2 + (h)) * HTB)
#define PG8_SB(b, h) ((4 + (b) * 2 + (h)) * HTB)
#define PG8_STAGE(bufoff, gbase, voff) do { _Pragma("unroll") for (int _i = 0; _i < 2; ++_i) \
        __builtin_amdgcn_global_load_lds((const unsigned*)((const char*)(gbase) + (voff)[_i]), (PG8_LAS unsigned*)(lds + (bufoff) + ldsw + _i * 8192), 16, 0, 0); } while (0)
#define PG8_LDA(dst, b, h) do { _Pragma("unroll") for (int m = 0; m < 4; ++m) _Pragma("unroll") for (int k = 0; k < 2; ++k) dst[m][k] = *(const PG8_LAS bf16x8*)(lds + PG8_SA(b, h) + aoff + m * 2048 + k * 1024); } while (0)
#define PG8_LDB(dst, b, h) do { _Pragma("unroll") for (int n = 0; n < 2; ++n) _Pragma("unroll") for (int k = 0; k < 2; ++k) dst[n][k] = *(const PG8_LAS bf16x8*)(lds + PG8_SB(b, h) + boff + n * 2048 + k * 1024); } while (0)
#define PG8_MMA(ai, bj, At, Bt) do { __builtin_amdgcn_s_setprio(1); _Pragma("unroll") for (int m = 0; m < 4; ++m) _Pragma("unroll") for (int n = 0; n < 2; ++n) _Pragma("unroll") for (int k = 0; k < 2; ++k) \
        acc[ai][bj][m][n] = __builtin_amdgcn_mfma_f32_16x16x32_bf16(Bt[n][k], At[m][k], acc[ai][bj][m][n], 0, 0, 0); __builtin_amdgcn_s_setprio(0); } while (0)
#define PG8_WAIT_V(n) asm volatile("s_waitcnt vmcnt(" #n ")" ::: "memory")
#define PG8_WAIT_L(n) asm volatile("s_waitcnt lgkmcnt(" #n ")" ::: "memory")
#define PG8_BAR __builtin_amdgcn_s_barrier()
#define PG8_SCHED __builtin_amdgcn_sched_barrier(0)
    Unit cur, nxt; int ui = 0;
    if (!S.next(0, cur)) return;
    f32x4 acc[2][2][4][2];
#pragma unroll
    for (int a = 0; a < 2; ++a)
#pragma unroll
        for (int b = 0; b < 2; ++b)
#pragma unroll
            for (int m = 0; m < 4; ++m)
#pragma unroll
                for (int n = 0; n < 2; ++n) acc[a][b][m][n] = (f32x4){0.f, 0.f, 0.f, 0.f};
    bf16x8 At[4][2], B0[2][2], B1[2][2];
    const char* cA = (const char*)g.A + (size_t)cur.pm * tstep; const char* cB = (const char*)g.Bt + (size_t)cur.pn * tstep;
    S.a_ready(cur);
    if constexpr (SP2) {
        PG8_STAGE(PG8_SB(0, 0), cB, voffB); PG8_STAGE(PG8_SB(0, 1), cB + hstep, voffB); PG8_STAGE(PG8_SA(0, 0), cA, voffA); PG8_STAGE(PG8_SA(0, 1), cA + hstep, voffA);
        if (wr == 1) PG8_BAR;
        PG8_WAIT_V(2); PG8_BAR;
        PG8_STAGE(PG8_SB(1, 0), cB + kstep, voffB); PG8_STAGE(PG8_SA(1, 0), cA + kstep, voffA); PG8_STAGE(PG8_SB(1, 1), cB + hstep + kstep, voffB);
        PG8_WAIT_V(6); PG8_BAR;
    } else {
        PG8_STAGE(PG8_SB(0, 0), cB, voffB); PG8_STAGE(PG8_SA(0, 0), cA, voffA); PG8_STAGE(PG8_SB(0, 1), cB + hstep, voffB); PG8_STAGE(PG8_SA(0, 1), cA + hstep, voffA);
        if (wr == 1) PG8_BAR;
        PG8_WAIT_V(4); PG8_BAR;
        PG8_STAGE(PG8_SB(1, 0), cB + kstep, voffB); PG8_STAGE(PG8_SA(1, 0), cA + kstep, voffA); PG8_STAGE(PG8_SB(1, 1), cB + hstep + kstep, voffB);
        PG8_WAIT_V(6); PG8_BAR;
    }
    for (;;) {
        const bool has_next = S.next(ui + 1, nxt);
        const char* nA = has_next ? (const char*)g.A + (size_t)nxt.pm * tstep : cA; const char* nB = has_next ? (const char*)g.Bt + (size_t)nxt.pn * tstep : cB;
        for (int t = 0; t < nt; t += 2) {
            const bool last = (t == nt - 2);
            const char* a1 = cA + (size_t)(t + 1) * kstep;
            const char* a2 = last ? nA : cA + (size_t)(t + 2) * kstep; const char* b2 = last ? nB : cB + (size_t)(t + 2) * kstep;
            const char* a3 = a2 + kstep; const char* b3 = b2 + kstep;
            if (last && has_next) S.a_ready(nxt);
            if ((E.mode & 4) && t == (nt >> 1)) {
#pragma unroll
                for (int ai = 0; ai < 2; ++ai)
#pragma unroll
                    for (int m = 0; m < 4; ++m) { __builtin_amdgcn_sched_barrier(0); const float rs_ = ((const PG8_LAS float*)(lds + STAGE_BYTES))[ui * 256 + ai * HALF + wr * 64 + m * 16 + fr];
#pragma unroll
                        for (int bj = 0; bj < 2; ++bj)
#pragma unroll
                            for (int n = 0; n < 2; ++n) acc[ai][bj][m][n] = acc[ai][bj][m][n] * rs_; }
            }
            if constexpr (SP2) {
            PG8_LDB(B0, 0, 0); PG8_LDB(B1, 0, 1); PG8_SCHED; PG8_LDA(At, 0, 0); PG8_STAGE(PG8_SA(1, 1), a1 + hstep, voffA);
            PG8_WAIT_V(8); PG8_WAIT_L(0); PG8_BAR; PG8_MMA(0, 0, At, B0); PG8_MMA(0, 1, At, B1); PG8_BAR; PG8_SCHED;
            PG8_LDA(At, 0, 1); PG8_STAGE(PG8_SB(0, 0), b2, voffB); PG8_STAGE(PG8_SB(0, 1), b2 + hstep, voffB); PG8_STAGE(PG8_SA(0, 0), a2, voffA);
            PG8_WAIT_V(8); PG8_WAIT_L(0); PG8_BAR; PG8_MMA(1, 0, At, B0); PG8_MMA(1, 1, At, B1); PG8_BAR; PG8_SCHED;
            PG8_LDB(B0, 1, 0); PG8_LDB(B1, 1, 1); PG8_SCHED; PG8_LDA(At, 1, 0); PG8_STAGE(PG8_SA(0, 1), a2 + hstep, voffA);
            PG8_WAIT_V(8); PG8_WAIT_L(0); PG8_BAR; PG8_MMA(0, 0, At, B0); PG8_MMA(0, 1, At, B1); PG8_BAR; PG8_SCHED;
            PG8_LDA(At, 1, 1); PG8_STAGE(PG8_SB(1, 0), b3, voffB); PG8_STAGE(PG8_SB(1, 1), b3 + hstep, voffB); PG8_STAGE(PG8_SA(1, 0), a3, voffA);
            PG8_WAIT_V(8); PG8_WAIT_L(0); PG8_BAR; PG8_MMA(1, 0, At, B0); PG8_MMA(1, 1, At, B1); PG8_BAR; PG8_SCHED;
            } else {
            PG8_LDB(B0, 0, 0); PG8_SCHED; PG8_LDA(At, 0, 0); PG8_STAGE(PG8_SA(1, 1), a1 + hstep, voffA);
            PG8_WAIT_L(8); PG8_BAR; PG8_WAIT_L(0); PG8_MMA(0, 0, At, B0); PG8_BAR; PG8_SCHED;
            PG8_LDB(B1, 0, 1); PG8_STAGE(PG8_SB(0, 0), b2, voffB);
            PG8_BAR; PG8_WAIT_L(0); PG8_MMA(0, 1, At, B1); PG8_BAR;
            PG8_LDA(At, 0, 1); PG8_STAGE(PG8_SA(0, 0), a2, voffA);
            PG8_BAR; PG8_WAIT_L(0); PG8_MMA(1, 0, At, B0); PG8_BAR; PG8_SCHED;
            PG8_STAGE(PG8_SB(0, 1), b2 + hstep, voffB);
            PG8_WAIT_V(6); PG8_BAR; PG8_MMA(1, 1, At, B1); PG8_BAR;
            PG8_LDB(B0, 1, 0); PG8_SCHED; PG8_LDA(At, 1, 0); PG8_STAGE(PG8_SA(0, 1), a2 + hstep, voffA);
            PG8_WAIT_L(8); PG8_BAR; PG8_WAIT_L(0); PG8_MMA(0, 0, At, B0); PG8_BAR; PG8_SCHED;
            PG8_LDB(B1, 1, 1); PG8_STAGE(PG8_SB(1, 0), b3, voffB);
            PG8_BAR; PG8_WAIT_L(0); PG8_MMA(0, 1, At, B1); PG8_BAR;
            PG8_LDA(At, 1, 1); PG8_STAGE(PG8_SA(1, 0), a3, voffA);
            PG8_BAR; PG8_WAIT_L(0); PG8_MMA(1, 0, At, B0); PG8_BAR; PG8_SCHED;
            PG8_STAGE(PG8_SB(1, 1), b3 + hstep, voffB);
            PG8_WAIT_V(6); PG8_BAR; PG8_MMA(1, 1, At, B1); PG8_BAR;
            }
        }
        if constexpr (ALIGN_EPI) { if (wr == 0) PG8_BAR; }
        if constexpr (!Epi::AFTER_DRAIN) { E(acc, cur, wr, wc, fr, fq); S.done(cur); }
        if (!has_next) break;
#pragma unroll
        for (int a = 0; a < 2; ++a)
#pragma unroll
            for (int b = 0; b < 2; ++b)
#pragma unroll
                for (int m = 0; m < 4; ++m)
#pragma unroll
                    for (int n = 0; n < 2; ++n) acc[a][b][m][n] = (f32x4){0.f, 0.f, 0.f, 0.f};
        cur = nxt; cA = nA; cB = nB; ++ui;
        if constexpr (ALIGN_EPI) { if (wr == 1) PG8_BAR; }
    }
    PG8_WAIT_V(0);
    if constexpr (!ALIGN_EPI) { if (wr == 0) PG8_BAR; }
    PG8_BAR;
    if constexpr (Epi::AFTER_DRAIN) { E.fused(acc, cur, wr, wc, fr, fq, lds, wid, lane); S.done(cur); }
#undef PG8_SA
#undef PG8_SB
#undef PG8_STAGE
#undef PG8_LDA
#undef PG8_LDB
#undef PG8_MMA
#undef PG8_WAIT_V
#undef PG8_WAIT_L
#undef PG8_BAR
#undef PG8_SCHED
}
}

#define LAS __attribute__((address_space(3)))
typedef unsigned short bf16;
typedef short bf16x8 __attribute__((ext_vector_type(8)));
typedef float f32x4 __attribute__((ext_vector_type(4)));
typedef unsigned u32x4 __attribute__((ext_vector_type(4)));
typedef unsigned u32x2 __attribute__((ext_vector_type(2)));

constexpr int D = 1024, NB = 16, SEQ = 4096, DEPTH = 4, DBT = 8, DSQ = 16;
constexpr int MP = NB * SEQ, MS = DBT * DSQ, MV = MP + MS, MT = 65792;
constexpr int NIN = 2560, INDIM = 2568, DFF = 4096, NSEQ = 24, PW = 2560;
constexpr float RMS_EPS = 1e-6f, LN_EPS = 1e-5f;
constexpr int NTHR = 512, LDS_BYTES = 159744;
#ifndef REP_MIX
#define REP_MIX 1
#endif
#ifndef REP_SSD
#define REP_SSD 1
#endif
#ifndef REP_CMLP
#define REP_CMLP 1
#endif
#ifndef REP_CONV
#define REP_CONV 1
#endif
#ifndef REP_SYNC
#define REP_SYNC 1
#endif
#define GSYNC() do { for (int rs_ = 0; rs_ < REP_SYNC; ++rs_) gbar(gb, tid); } while (0)
#ifndef REP_NORM
#define REP_NORM 1
#endif
#ifndef REP_GEMM
#define REP_GEMM 1
#endif
#ifndef REP_PREP
#define REP_PREP 1
#endif
#ifndef REP_FIN
#define REP_FIN 1
#endif

constexpr size_t O_YP = 0, O_YS = 67108864, O_CP = 67239936, O_SP = 67436544, O_CS = 71630848, O_SS = 71729152, O_VS = 73826304;
constexpr size_t WS_WIN = 0;
constexpr size_t WS_WOUT = WS_WIN + (size_t)DEPTH * NIN * D * 2;
constexpr size_t WS_WFF1 = WS_WOUT + (size_t)DEPTH * D * D * 2;
constexpr size_t WS_WFF2 = WS_WFF1 + (size_t)DEPTH * DFF * D * 2;
constexpr size_t WS_WS = WS_WFF2 + (size_t)DEPTH * DFF * D * 2;
constexpr size_t WS_WDT = WS_WS + (size_t)DEPTH * 4 * 128 * 128 * 2;
constexpr size_t WS_MOD = WS_WDT + (size_t)DEPTH * 8 * 1024 * 4;
constexpr size_t WS_DT = WS_MOD + (size_t)DEPTH * NSEQ * 6144 * 4;
constexpr size_t WS_SSQ = WS_DT + (size_t)MT * 8 * 4;
constexpr size_t WS_H = 104857600;
constexpr size_t WS_MF = WS_H + (size_t)MT * D * 2;
constexpr size_t WS_BIG = WS_MF + (size_t)MT * D * 2;
constexpr size_t WS_XB = WS_BIG + (size_t)MT * DFF * 2;
constexpr size_t WS_SSQ2 = WS_XB + (size_t)MT * D * 2;
constexpr size_t WS_END = WS_SSQ2 + (size_t)MT * 16 * 4;
static_assert(WS_SSQ + (size_t)MT * 8 * 4 <= WS_H, "ws map");
static_assert(WS_END <= (size_t)1073741824, "ws map end");

struct Args { const float* in[23]; float* out; unsigned char* ws; };

__device__ __forceinline__ unsigned pk2(float lo, float hi) { return pg8::cvt_pk_bf16(lo, hi); }
__device__ __forceinline__ float bflo(unsigned u) { return __uint_as_float(u << 16); }
__device__ __forceinline__ float bfhi(unsigned u) { return __uint_as_float(u & 0xffff0000u); }
__device__ __forceinline__ float bf2f(unsigned short b) { return __uint_as_float(((unsigned)b) << 16); }
__device__ __forceinline__ float wave_sum(float v) {
#pragma unroll
    for (int o = 1; o < 64; o <<= 1) v += __shfl_xor(v, o);
    return v;
}
__device__ __forceinline__ float silu_f(float x) { return x * __builtin_amdgcn_rcpf(1.0f + __builtin_amdgcn_exp2f(-1.4426950409f * x)); }
__device__ __forceinline__ int hide(int v) { asm volatile("" : "+v"(v)); return v; }
#define DPP_STEP(v, ctrl, rmask) do { const int t_ = __builtin_amdgcn_update_dpp(0, __float_as_int(v), (ctrl), (rmask), 0xf, false); v += __int_as_float(t_); } while (0)
__device__ __forceinline__ float wave_scan_incl(float v) {
    DPP_STEP(v, 0x111, 0xf); DPP_STEP(v, 0x112, 0xf); DPP_STEP(v, 0x114, 0xf); DPP_STEP(v, 0x118, 0xf);
    DPP_STEP(v, 0x142, 0xa); DPP_STEP(v, 0x143, 0xc);
    return v;
}
__device__ __forceinline__ f32x4 mfma16(bf16x8 a, bf16x8 b, f32x4 c) { return __builtin_amdgcn_mfma_f32_16x16x32_bf16(a, b, c, 0, 0, 0); }

struct GBar { unsigned* w; unsigned gen, xcc, nloc, nx; };
__device__ __forceinline__ unsigned gb_ld(unsigned* p) { return __hip_atomic_load(p, __ATOMIC_RELAXED, __HIP_MEMORY_SCOPE_AGENT); }
__device__ __forceinline__ void gbar(GBar& b, int tid) {
    __syncthreads();
    if (tid == 0) {
        __builtin_amdgcn_fence(__ATOMIC_RELEASE, "agent");
        const unsigned g1 = b.gen + 1u;
        const unsigned old = __hip_atomic_fetch_add(b.w + 64 * b.xcc, 1u, __ATOMIC_RELAXED, __HIP_MEMORY_SCOPE_AGENT);
        if (old + 1u == g1 * b.nloc) {
            __builtin_amdgcn_fence(__ATOMIC_ACQ_REL, "agent");
            const unsigned ot = __hip_atomic_fetch_add(b.w + 512, 1u, __ATOMIC_RELAXED, __HIP_MEMORY_SCOPE_AGENT);
            if (ot + 1u == g1 * b.nx) {
                __builtin_amdgcn_fence(__ATOMIC_ACQ_REL, "agent");
#pragma unroll
                for (int j = 0; j < 8; ++j) __hip_atomic_store(b.w + 576 + 64 * j, g1, __ATOMIC_RELAXED, __HIP_MEMORY_SCOPE_AGENT);
            }
        }
        while (gb_ld(b.w + 576 + 64 * b.xcc) < g1) __builtin_amdgcn_s_sleep(1);
        __builtin_amdgcn_fence(__ATOMIC_ACQUIRE, "agent");
    }
    __syncthreads();
    ++b.gen;
}

__device__ __forceinline__ void transpose_item(const float* W, int Nsrc, int K, bf16* WT, LAS float* scr, int kb, int nb, int shift_from, int lane, const float* kscale) {
    const int k0 = 64 * kb, n0 = 32 * nb, sn0 = n0 + (n0 >= shift_from ? 8 : 0);
#pragma unroll 8
    for (int i = 0; i < 32; ++i) { const int kk = 2 * i + (lane >> 5); float wv = W[(size_t)(k0 + kk) * Nsrc + sn0 + (lane & 31)]; if (kscale != nullptr && k0 + kk < 512) wv *= kscale[k0 + kk]; scr[kk * 33 + (lane & 31)] = wv; }
    asm volatile("s_waitcnt lgkmcnt(0)" ::: "memory");
    const int c = lane & 7;
#pragma unroll
    for (int j = 0; j < 4; ++j) { const int n = (lane >> 3) + 8 * j; const LAS float* s = scr + (8 * c) * 33 + n;
        u32x4 o; o.x = pk2(s[0 * 33], s[1 * 33]); o.y = pk2(s[2 * 33], s[3 * 33]); o.z = pk2(s[4 * 33], s[5 * 33]); o.w = pk2(s[6 * 33], s[7 * 33]);
        *(u32x4*)(WT + (size_t)(n0 + n) * K + k0 + 8 * c) = o; }
    asm volatile("s_waitcnt lgkmcnt(0)" ::: "memory");
}

__device__ __forceinline__ void prep_transposes(LAS unsigned char* L, const Args& a, int lo, int hi, int gw, int NGW, int lane, int wave) {
    unsigned char* ws = a.ws;
    LAS float* scr = (LAS float*)(L + wave * 8448);
    constexpr int I_IN = 16 * 80, I_OUT = 16 * 32, I_F1 = 16 * 128, I_F2 = 64 * 32, I_L = I_IN + I_OUT + I_F1 + I_F2;
    for (int it = lo * I_L + gw; it < hi * I_L; it += NGW) {
        const int l = it / I_L; int r = it - l * I_L;
        if (r < I_IN) { transpose_item(a.in[9] + (size_t)l * D * INDIM, INDIM, D, (bf16*)(ws + WS_WIN) + (size_t)l * NIN * D, scr, r / 80, r % 80, 1536, lane, nullptr); continue; }
        r -= I_IN;
        if (r < I_OUT) { transpose_item(a.in[20] + (size_t)l * D * D, D, D, (bf16*)(ws + WS_WOUT) + (size_t)l * D * D, scr, r / 32, r % 32, 1 << 30, lane, a.in[15] + l * 512); continue; }
        r -= I_OUT;
        if (r < I_F1) { transpose_item(a.in[21] + (size_t)l * D * DFF, DFF, D, (bf16*)(ws + WS_WFF1) + (size_t)l * DFF * D, scr, r / 128, r % 128, 1 << 30, lane, nullptr); continue; }
        r -= I_F1;
        transpose_item(a.in[22] + (size_t)l * DFF * D, D, DFF, (bf16*)(ws + WS_WFF2) + (size_t)l * D * DFF, scr, r / 32, r % 32, 1 << 30, lane, nullptr);
    }
}

__device__ __forceinline__ void prep_phase(LAS unsigned char* L, const Args& a, int bid, int G, int tid) {
    const int lane = tid & 63, wave = tid >> 6;
    unsigned char* ws = a.ws;
    prep_transposes(L, a, 0, 1, bid * 8 + wave, G * 8, lane, wave);
    {
        const int gt = bid * NTHR + tid, NGT = G * NTHR;
        const float* w_s = a.in[18]; bf16* WS = (bf16*)(ws + WS_WS);
        for (int i = gt; i < DEPTH * 4 * 128 * 128; i += NGT) { const int jj = i & 127, ii = (i >> 7) & 127; WS[i] = (bf16)(pk2(jj <= ii ? w_s[i] : 0.f, 0.f) & 0xffffu); }
        float* WDT = (float*)(ws + WS_WDT);
        for (int i = gt; i < DEPTH * 8 * 1024; i += NGT) { const int k = i & 1023, hd = (i >> 10) & 7, l = i >> 13; WDT[i] = a.in[9][((size_t)l * D + k) * INDIM + 1536 + hd]; }
    }
    __syncthreads();
    {
        LAS float* SC = (LAS float*)L;
        LAS float* RED = (LAS float*)(L + 98304);
        for (int i = tid; i < NSEQ * 1024; i += NTHR) { const int s = i >> 10, k = i & 1023; const float c = s < 16 ? a.in[4][s * 1024 + k] : a.in[5][(s - 16) * 1024 + k]; SC[k * 24 + s] = silu_f(c); }
        __syncthreads();
        float* MOD = (float*)(ws + WS_MOD);
        for (int u = bid; u < DEPTH * 96; u += G) {
            const int l = u / 96, n0 = (u % 96) * 64;
            const float* wm = a.in[6] + (size_t)l * D * 6144 + n0 + lane;
            float acc[24];
#pragma unroll
            for (int s = 0; s < 24; ++s) acc[s] = 0.f;
            for (int kb = 0; kb < 8; ++kb) {
                float wv[16];
#pragma unroll
                for (int i = 0; i < 16; ++i) wv[i] = wm[(size_t)(wave * 128 + kb * 16 + i) * 6144];
#pragma unroll
                for (int i = 0; i < 16; ++i) { const int k = wave * 128 + kb * 16 + i;
#pragma unroll
                    for (int s4 = 0; s4 < 6; ++s4) { const f32x4 c4 = *(const LAS f32x4*)(SC + k * 24 + 4 * s4);
                        acc[4 * s4 + 0] += c4.x * wv[i]; acc[4 * s4 + 1] += c4.y * wv[i]; acc[4 * s4 + 2] += c4.z * wv[i]; acc[4 * s4 + 3] += c4.w * wv[i]; } }
            }
#pragma unroll
            for (int s = 0; s < 24; ++s) RED[(wave * 24 + s) * 64 + lane] = acc[s];
            __syncthreads();
            for (int o = tid; o < 1536; o += NTHR) { const int s = o >> 6, col = o & 63; float v = a.in[7][l * 6144 + n0 + col];
#pragma unroll
                for (int w = 0; w < 8; ++w) v += RED[(w * 24 + s) * 64 + col];
                MOD[((size_t)l * NSEQ + s) * 6144 + n0 + col] = v; }
            __syncthreads();
        }
    }
}

struct NormCfg {
    const float* xsrc_p; const float* xsrc_s; float* xdst_p; float* xdst_s; const bf16* xb_src; bf16* xb_dst;
    const bf16* mf; const float* gate; const float* ngpost;
    const float* ngpre; const float* sc; const float* sh; bf16* H;
    const float* wdt; const float* dtbias; float* DT;
};
template <int CTRL> __device__ __forceinline__ float dppf(float v) { return __int_as_float(__builtin_amdgcn_update_dpp(0, __float_as_int(v), CTRL, 0xf, 0xf, false)); }
__device__ __forceinline__ float sx1(float v) { return dppf<0xB1>(v); }
__device__ __forceinline__ float sx2(float v) { return dppf<0x4E>(v); }
__device__ __forceinline__ float sx4(float v) { return dppf<0x1B>(dppf<0x141>(v)); }
__device__ __forceinline__ float sx8(float v) { return dppf<0x128>(v); }
__device__ __forceinline__ float add_x16(float v) { const unsigned u = __float_as_uint(v); const auto r = __builtin_amdgcn_permlane16_swap(u, u, false, false); return __uint_as_float(r[0]) + __uint_as_float(r[1]); }
__device__ __forceinline__ float add_x32(float v) { const unsigned u = __float_as_uint(v); const auto r = __builtin_amdgcn_permlane32_swap(u, u, false, false); return __uint_as_float(r[0]) + __uint_as_float(r[1]); }
__device__ __forceinline__ void reduce4(const float (&s)[4], int lane, float (&tot)[4]) {
    const bool b0 = lane & 1, b1 = lane & 2;
    const float e0 = (b0 ? s[2] : s[0]) + sx1(b0 ? s[0] : s[2]);
    const float e1 = (b0 ? s[3] : s[1]) + sx1(b0 ? s[1] : s[3]);
    float f = (b1 ? e1 : e0) + sx2(b1 ? e0 : e1);
    f += sx4(f); f += sx8(f); f = add_x16(f); f = add_x32(f);
    tot[0] = __builtin_amdgcn_readlane(f, 0); tot[1] = __builtin_amdgcn_readlane(f, 2); tot[2] = __builtin_amdgcn_readlane(f, 1); tot[3] = __builtin_amdgcn_readlane(f, 3);
}
__device__ __forceinline__ float reduce8(const float (&d)[8], int lane) {
    const bool b0 = lane & 1, b1 = lane & 2, b2 = lane & 4;
    float e[4], f[2];
#pragma unroll
    for (int k = 0; k < 4; ++k) e[k] = (b0 ? d[4 + k] : d[k]) + sx1(b0 ? d[k] : d[4 + k]);
#pragma unroll
    for (int k = 0; k < 2; ++k) f[k] = (b1 ? e[2 + k] : e[k]) + sx2(b1 ? e[k] : e[2 + k]);
    float g = (b2 ? f[1] : f[0]) + sx4(b2 ? f[0] : f[1]);
    g += sx8(g); g = add_x16(g); g = add_x32(g);
    return g;
}
__device__ __forceinline__ void reduce2(const float (&s)[2], int lane, float (&tot)[2]) {
    const bool b0 = lane & 1;
    float f = (b0 ? s[1] : s[0]) + __shfl_xor(b0 ? s[0] : s[1], 1);
    f += __shfl_xor(f, 2); f += __shfl_xor(f, 4); f += __shfl_xor(f, 8); f += __shfl_xor(f, 16); f += __shfl_xor(f, 32);
    tot[0] = __builtin_amdgcn_readlane(f, 0); tot[1] = __builtin_amdgcn_readlane(f, 1);
}
#define NCOL(q) (512 * ((q) >> 1) + 8 * lane + 4 * ((q) & 1))
__device__ __forceinline__ void norm_pass(LAS unsigned char* L, const NormCfg c, int bid, int G, int tid) {
    const int lane = tid & 63, wave = tid >> 6;
    const bool has_post = c.mf != nullptr, has_pre = c.ngpre != nullptr, has_dt = c.wdt != nullptr;
    if (has_dt) {
        for (int i = tid; i < 2048; i += NTHR) ((LAS f32x4*)L)[i] = ((const f32x4*)c.wdt)[i];
        __syncthreads();
    }
    const int gw = bid * 8 + wave, NGW = G * 8;
    for (int sl = gw; sl < MV / 32; sl += NGW) {
        for (int it = 0; it < 8; ++it) {
            const int rbase = sl * 32 + it * 4;
            const bool isp = rbase < MP; const int seq = isp ? (rbase >> 12) : (16 + ((rbase - MP) >> 4));
            const size_t xoff = (isp ? (size_t)rbase * D : (size_t)(rbase - MP) * D);
            const float* xs = (isp ? c.xsrc_p : c.xsrc_s) + xoff;
            const unsigned voff = (unsigned)seq * 6144u;
            f32x4 x[4][4];
            if (c.xb_src != nullptr) {
                const bf16* xb = c.xb_src + (size_t)rbase * D + 8 * lane;
#pragma unroll
                for (int rr = 0; rr < 4; ++rr)
#pragma unroll
                    for (int Q = 0; Q < 2; ++Q) { const u32x4 t4 = __builtin_nontemporal_load((const u32x4*)(xb + rr * D + 512 * Q));
                        x[rr][2 * Q] = (f32x4){bflo(t4.x), bfhi(t4.x), bflo(t4.y), bfhi(t4.y)}; x[rr][2 * Q + 1] = (f32x4){bflo(t4.z), bfhi(t4.z), bflo(t4.w), bfhi(t4.w)}; }
            } else {
#pragma unroll
                for (int rr = 0; rr < 4; ++rr)
#pragma unroll
                    for (int q = 0; q < 4; ++q) x[rr][q] = __builtin_nontemporal_load((const f32x4*)(xs + rr * D + NCOL(q)));
            }
            if (has_post) {
                const bf16* mr = c.mf + (size_t)rbase * D + 8 * lane;
                u32x4 mm[4][2];
#pragma unroll
                for (int rr = 0; rr < 4; ++rr)
#pragma unroll
                    for (int Q = 0; Q < 2; ++Q) mm[rr][Q] = __builtin_nontemporal_load((const u32x4*)(mr + rr * D + 512 * Q));
                float ss[4], tot[4];
#pragma unroll
                for (int rr = 0; rr < 4; ++rr) { float a = 0.f;
#pragma unroll
                    for (int Q = 0; Q < 2; ++Q) { const u32x4 t = mm[rr][Q]; const float m0 = bflo(t.x), m1 = bfhi(t.x), m2 = bflo(t.y), m3 = bfhi(t.y), m4 = bflo(t.z), m5 = bfhi(t.z), m6 = bflo(t.w), m7 = bfhi(t.w);
                        a += ((m0 * m0 + m1 * m1) + (m2 * m2 + m3 * m3)) + ((m4 * m4 + m5 * m5) + (m6 * m6 + m7 * m7)); }
                    ss[rr] = a; }
                reduce4(ss, lane, tot);
#pragma unroll
                for (int rr = 0; rr < 4; ++rr) tot[rr] = rsqrtf(tot[rr] * (1.0f / D) + RMS_EPS);
                float* xd = (isp ? c.xdst_p : c.xdst_s) + xoff; bf16* xbd = c.xb_dst + (size_t)rbase * D + 8 * lane; const bool st_bf = c.xb_dst != nullptr;
#pragma unroll
                for (int Q = 0; Q < 2; ++Q) {
                    const f32x4 gn0 = *(const f32x4*)(c.gate + voff + NCOL(2 * Q)) * *(const f32x4*)(c.ngpost + NCOL(2 * Q));
                    const f32x4 gn1 = *(const f32x4*)(c.gate + voff + NCOL(2 * Q + 1)) * *(const f32x4*)(c.ngpost + NCOL(2 * Q + 1));
#pragma unroll
                    for (int rr = 0; rr < 4; ++rr) { const u32x4 t = mm[rr][Q];
                        x[rr][2 * Q] = x[rr][2 * Q] + gn0 * ((f32x4){bflo(t.x), bfhi(t.x), bflo(t.y), bfhi(t.y)} * tot[rr]);
                        x[rr][2 * Q + 1] = x[rr][2 * Q + 1] + gn1 * ((f32x4){bflo(t.z), bfhi(t.z), bflo(t.w), bfhi(t.w)} * tot[rr]);
                        if (st_bf) { u32x4 o; o.x = pk2(x[rr][2 * Q].x, x[rr][2 * Q].y); o.y = pk2(x[rr][2 * Q].z, x[rr][2 * Q].w); o.z = pk2(x[rr][2 * Q + 1].x, x[rr][2 * Q + 1].y); o.w = pk2(x[rr][2 * Q + 1].z, x[rr][2 * Q + 1].w);
                            __builtin_nontemporal_store(o, (u32x4*)(xbd + rr * D + 512 * Q)); }
                        else { __builtin_nontemporal_store(x[rr][2 * Q], (f32x4*)(xd + rr * D + NCOL(2 * Q))); __builtin_nontemporal_store(x[rr][2 * Q + 1], (f32x4*)(xd + rr * D + NCOL(2 * Q + 1))); } } }
            }
            if (has_pre) {
                float ss[4], tot[4];
#pragma unroll
                for (int rr = 0; rr < 4; ++rr) { float a = 0.f;
#pragma unroll
                    for (int q = 0; q < 4; ++q) a += (x[rr][q].x * x[rr][q].x + x[rr][q].y * x[rr][q].y) + (x[rr][q].z * x[rr][q].z + x[rr][q].w * x[rr][q].w);
                    ss[rr] = a; }
                reduce4(ss, lane, tot);
#pragma unroll
                for (int rr = 0; rr < 4; ++rr) tot[rr] = rsqrtf(tot[rr] * (1.0f / D) + RMS_EPS);
                bf16* hr = c.H + (size_t)rbase * D + 8 * lane;
#pragma unroll
                for (int Q = 0; Q < 2; ++Q) {
                    const f32x4 ns0 = *(const f32x4*)(c.ngpre + NCOL(2 * Q)) * (*(const f32x4*)(c.sc + voff + NCOL(2 * Q)) + 1.0f), sh0 = *(const f32x4*)(c.sh + voff + NCOL(2 * Q));
                    const f32x4 ns1 = *(const f32x4*)(c.ngpre + NCOL(2 * Q + 1)) * (*(const f32x4*)(c.sc + voff + NCOL(2 * Q + 1)) + 1.0f), sh1 = *(const f32x4*)(c.sh + voff + NCOL(2 * Q + 1));
#pragma unroll
                    for (int rr = 0; rr < 4; ++rr) { x[rr][2 * Q] = (x[rr][2 * Q] * tot[rr]) * ns0 + sh0; x[rr][2 * Q + 1] = (x[rr][2 * Q + 1] * tot[rr]) * ns1 + sh1;
                        u32x4 o; o.x = pk2(x[rr][2 * Q].x, x[rr][2 * Q].y); o.y = pk2(x[rr][2 * Q].z, x[rr][2 * Q].w); o.z = pk2(x[rr][2 * Q + 1].x, x[rr][2 * Q + 1].y); o.w = pk2(x[rr][2 * Q + 1].z, x[rr][2 * Q + 1].w);
                        *(u32x4*)(hr + rr * D + 512 * Q) = o; } }
                if (has_dt) {
                    const int hd_l = ((lane & 1) << 2) | (lane & 2) | ((lane >> 2) & 1);
                    const float db = c.dtbias[hd_l];
#pragma unroll
                    for (int rp = 0; rp < 2; ++rp) {
                        float d[2][8];
#pragma unroll
                        for (int hd = 0; hd < 8; ++hd) { float a0 = 0.f, a1 = 0.f;
#pragma unroll
                            for (int q = 0; q < 4; ++q) { const f32x4 w4 = *(const LAS f32x4*)(L + (size_t)(hd * 1024 + NCOL(q)) * 4);
                                const f32x4 xa = x[2 * rp][q], xb = x[2 * rp + 1][q];
                                a0 += (xa.x * w4.x + xa.y * w4.y) + (xa.z * w4.z + xa.w * w4.w); a1 += (xb.x * w4.x + xb.y * w4.y) + (xb.z * w4.z + xb.w * w4.w); }
                            d[0][hd] = a0; d[1][hd] = a1; }
#pragma unroll
                        for (int r2 = 0; r2 < 2; ++r2) { const float gsum = reduce8(d[r2], lane);
                            if (lane < 8) { const float v = gsum + db; c.DT[(size_t)(rbase + 2 * rp + r2) * 8 + hd_l] = v > 20.f ? v : log1pf(expf(v)); } }
                    }
                }
            }
        }
    }
    if (has_dt) __syncthreads();
}

struct MixCtx {
    const bf16* P; bf16* Y; const float* DT; const bf16* WS; bf16* XC; float* SSQ2;
    const float* state_conv; const float* state_ssd; const float* conv_w; const float* conv_b; const float* a_log; const float* d_skip;
    const float* v_ln_g; const float* v_ln_b; const float* b_s; float* out;
};
__device__ __forceinline__ void conv_unit(const MixCtx& X, int l, int s, int c, bool smp, int tid) {
    const int nvalid = smp ? 16 : 64, row0 = smp ? MP + s * DSQ : s * SEQ + c * 64;
    const int ch = 2 * tid;
    const bf16* Pc = X.P + (size_t)row0 * PW + 512 + ch;
    unsigned raw[67];
#pragma unroll
    for (int i = 0; i < 3; ++i) { unsigned v = 0u;
        if (smp) { const float* sp = X.state_conv + ((size_t)(l * DBT + s) * 3 + i) * 1024 + ch; v = pk2(sp[0], sp[1]); }
        else if (c > 0) v = *(const unsigned*)(Pc + (i - 3) * PW);
        raw[i] = v; }
#pragma unroll
    for (int t = 0; t < 64; ++t) raw[3 + t] = (t < nvalid) ? __builtin_nontemporal_load((const unsigned*)(Pc + t * PW)) : 0u;
    float w[4][2], bia[2];
#pragma unroll
    for (int k = 0; k < 4; ++k) { const float2 w2 = *(const float2*)(X.conv_w + (l * 4 + k) * 1024 + ch); w[k][0] = w2.x; w[k][1] = w2.y; }
    { const float2 b2 = *(const float2*)(X.conv_b + l * 1024 + ch); bia[0] = b2.x; bia[1] = b2.y; }
    bf16* xo = X.XC + (size_t)row0 * 1024 + ch;
#pragma unroll
    for (int t = 0; t < 64; ++t) { float v0 = bia[0], v1 = bia[1];
#pragma unroll
        for (int k = 0; k < 4; ++k) { v0 += w[k][0] * bflo(raw[t + k]); v1 += w[k][1] * bfhi(raw[t + k]); }
        if (t < nvalid) *(unsigned*)(xo + (size_t)t * 1024) = pk2(silu_f(v0), silu_f(v1)); }
    if (smp || c == 63) {
        float* co = X.out + (smp ? O_CS : O_CP) + (size_t)(l * (smp ? DBT : NB) + s) * 3 * 1024 + ch;
        const unsigned r0 = smp ? raw[3 + 13] : raw[3 + 61], r1 = smp ? raw[3 + 14] : raw[3 + 62], r2 = smp ? raw[3 + 15] : raw[3 + 63];
        *(float2*)(co) = make_float2(bflo(r0), bfhi(r0)); *(float2*)(co + 1024) = make_float2(bflo(r1), bfhi(r1)); *(float2*)(co + 2048) = make_float2(bflo(r2), bfhi(r2));
    }
}

constexpr int SL_XT = 0, SL_XWT = 9216, SL_LM = 18432, SL_BN = 27648, SL_CN = 45056, SL_HB = 62464, SL_BT = 79872, SL_YS = 98304, SL_SC = 115712;

#define SSD_LOAD_RAW(cc) do { \
    const char* Pb_ = (const char*)(X.XC + (size_t)(row0 + (cc) * 64) * 1024); \
    _Pragma("unroll") for (int i_ = 0; i_ < 4; ++i_) { const int t_ = min(4 * sx + i_, nvalid - 1); rawx[i_] = *(const unsigned*)(Pb_ + (unsigned)((t_ * 1024 + chx) * 2)); } \
    _Pragma("unroll") for (int i_ = 0; i_ < 8; ++i_) { const int t_ = min(8 * sb + i_, nvalid - 1); rawb[i_] = *(const unsigned*)(Pb_ + (unsigned)((t_ * 1024 + chb) * 2)); rawc[i_] = *(const unsigned*)(Pb_ + (unsigned)((t_ * 1024 + chc) * 2)); } \
} while (0)

__device__ __forceinline__ void ssd_unit(LAS unsigned char* L, const MixCtx& X, int l, int b, int h, bool smp, int tid) {
    const int lane = tid & 63, wave = tid >> 6, fr = lane & 15, fq = lane >> 4;
    const int g = h >> 2;
    const int nch = smp ? 1 : 64, nvalid = smp ? 16 : 64, row0 = smp ? MP + b * DSQ : b * SEQ;
    const float A_h = -expf(X.a_log[l * 8 + h]), dsk = X.d_skip[l * 8 + h];
    const int cx = tid & 31, sx = tid >> 5, cb = tid & 63, sb = tid >> 6;
    const int chx = h * 64 + 2 * cx, chb = 512 + g * 128 + 2 * cb, chc = 768 + g * 128 + 2 * cb;
    LAS bf16* XT = (LAS bf16*)(L + SL_XT); LAS bf16* XWT = (LAS bf16*)(L + SL_XWT); LAS bf16* LM = (LAS bf16*)(L + SL_LM);
    LAS bf16* BN = (LAS bf16*)(L + SL_BN); LAS bf16* CN = (LAS bf16*)(L + SL_CN); LAS bf16* HB = (LAS bf16*)(L + SL_HB);
    LAS bf16* BT = (LAS bf16*)(L + SL_BT); LAS float* YS = (LAS float*)(L + SL_YS); LAS float* SCa = (LAS float*)(L + SL_SC); LAS float* SCd = SCa + 64;
    const int tp_s = wave >> 1, tn0 = (wave & 1) * 4, ti = wave >> 1, t2 = (wave & 1) * 2;
    const size_t sbase = smp ? (((size_t)(l * DBT + b) * 8 + h) * 64) * 128 : 0;
    f32x4 hacc[4];
#pragma unroll
    for (int a = 0; a < 4; ++a)
#pragma unroll
        for (int r = 0; r < 4; ++r) { const int p = 16 * tp_s + 4 * fq + r, n = 16 * (tn0 + a) + fr;
            const float v = smp ? X.state_ssd[sbase + (size_t)p * 128 + n] : 0.f; hacc[a][r] = v; HB[p * 136 + n] = (bf16)(pk2(v, 0.f) & 0xffffu); }
    unsigned rawx[4], rawb[8], rawc[8];
    SSD_LOAD_RAW(0);
    float dtv; { const float d0_ = X.DT[(size_t)(row0 + min(lane, nvalid - 1)) * 8 + h]; dtv = (lane < nvalid) ? d0_ : 0.f; }
    __syncthreads();
    for (int c = 0; c < nch; ++c) {
        const int zi = tid >> 3, zp0 = (tid & 7) * 8;
        const u32x4 zreg = *(const u32x4*)(X.P + (size_t)(row0 + c * 64 + min(zi, nvalid - 1)) * PW + h * 64 + zp0);
        const float acum = wave_scan_incl(dtv * A_h);
        const float a_last = __int_as_float(__builtin_amdgcn_readlane(__float_as_int(acum), 63));
        const float wend = __expf(a_last - acum) * dtv;
        if (wave == 0) { SCa[lane] = acum; SCd[lane] = dtv; }
        {
            float x0[4], x1[4], w0[4], w1[4];
#pragma unroll
            for (int jj = 0; jj < 4; ++jj) { const int t = 4 * sx + jj; float v0 = bflo(rawx[jj]), v1 = bfhi(rawx[jj]); if (t >= nvalid) { v0 = 0.f; v1 = 0.f; }
                const int wv_ = __builtin_amdgcn_readfirstlane(tid >> 6);
                const float we_lo = __int_as_float(__builtin_amdgcn_readlane(__float_as_int(wend), 8 * wv_ + jj)), we_hi = __int_as_float(__builtin_amdgcn_readlane(__float_as_int(wend), 8 * wv_ + 4 + jj));
                const float we = (lane & 32) ? we_hi : we_lo;
                x0[jj] = v0; x1[jj] = v1; w0[jj] = v0 * we; w1[jj] = v1 * we; }
            u32x2 o;
            o.x = pk2(x0[0], x0[1]); o.y = pk2(x0[2], x0[3]); *(LAS u32x2*)(XT + (2 * cx) * 72 + 4 * sx) = o;
            o.x = pk2(x1[0], x1[1]); o.y = pk2(x1[2], x1[3]); *(LAS u32x2*)(XT + (2 * cx + 1) * 72 + 4 * sx) = o;
            o.x = pk2(w0[0], w0[1]); o.y = pk2(w0[2], w0[3]); *(LAS u32x2*)(XWT + (2 * cx) * 72 + 4 * sx) = o;
            o.x = pk2(w1[0], w1[1]); o.y = pk2(w1[2], w1[3]); *(LAS u32x2*)(XWT + (2 * cx + 1) * 72 + 4 * sx) = o;
        }
        {
#pragma unroll
            for (int jj = 0; jj < 8; ++jj) { const int t = 8 * sb + jj; if (t >= nvalid) { rawb[jj] = 0u; rawc[jj] = 0u; }
                *(LAS unsigned*)(BN + t * 136 + 2 * cb) = rawb[jj];
                *(LAS unsigned*)(CN + t * 136 + 2 * cb) = rawc[jj]; }
            u32x4 o;
            o.x = (rawb[0] & 0xffffu) | (rawb[1] << 16); o.y = (rawb[2] & 0xffffu) | (rawb[3] << 16); o.z = (rawb[4] & 0xffffu) | (rawb[5] << 16); o.w = (rawb[6] & 0xffffu) | (rawb[7] << 16); *(LAS u32x4*)(BT + (2 * cb) * 72 + 8 * sb) = o;
            o.x = (rawb[0] >> 16) | (rawb[1] & 0xffff0000u); o.y = (rawb[2] >> 16) | (rawb[3] & 0xffff0000u); o.z = (rawb[4] >> 16) | (rawb[5] & 0xffff0000u); o.w = (rawb[6] >> 16) | (rawb[7] & 0xffff0000u); *(LAS u32x4*)(BT + (2 * cb + 1) * 72 + 8 * sb) = o;
        }
        __syncthreads();
        { const int cn = min(c + 1, nch - 1); SSD_LOAD_RAW(cn); const float dn_ = X.DT[(size_t)(row0 + cn * 64 + min(lane, nvalid - 1)) * 8 + h]; dtv = (lane < nvalid) ? dn_ : 0.f; }
        f32x4 cbacc[2], yoff[2];
#pragma unroll
        for (int e = 0; e < 2; ++e) { cbacc[e] = (f32x4){0.f, 0.f, 0.f, 0.f}; yoff[e] = (f32x4){0.f, 0.f, 0.f, 0.f}; }
#pragma unroll
        for (int kk = 0; kk < 4; ++kk) {
            const bf16x8 af = *(const LAS bf16x8*)(CN + (16 * ti + fr) * 136 + 32 * kk + 8 * fq);
#pragma unroll
            for (int e = 0; e < 2; ++e) {
                const bf16x8 bf_ = *(const LAS bf16x8*)(BN + (16 * (t2 + e) + fr) * 136 + 32 * kk + 8 * fq);
                const bf16x8 hf = *(const LAS bf16x8*)(HB + (16 * (t2 + e) + fr) * 136 + 32 * kk + 8 * fq);
                cbacc[e] = mfma16(af, bf_, cbacc[e]); yoff[e] = mfma16(af, hf, yoff[e]); }
        }
        float ai4[4];
#pragma unroll
        for (int r = 0; r < 4; ++r) ai4[r] = SCa[16 * ti + 4 * fq + r];
#pragma unroll
        for (int e = 0; e < 2; ++e) { const int j = 16 * (t2 + e) + fr; const float aj = SCa[j], dj = SCd[j];
#pragma unroll
            for (int r = 0; r < 4; ++r) { const int i = 16 * ti + 4 * fq + r;
                const float val = (i >= j) ? cbacc[e][r] * __expf(fminf(ai4[r] - aj, 0.f)) * dj : 0.f;
                LM[i * 72 + j] = (bf16)(pk2(val, 0.f) & 0xffffu); } }
        __syncthreads();
        f32x4 yd[2];
#pragma unroll
        for (int e = 0; e < 2; ++e) yd[e] = (f32x4){0.f, 0.f, 0.f, 0.f};
#pragma unroll
        for (int kk = 0; kk < 2; ++kk) {
            const bf16x8 af = *(const LAS bf16x8*)(LM + (16 * ti + fr) * 72 + 32 * kk + 8 * fq);
#pragma unroll
            for (int e = 0; e < 2; ++e) { const bf16x8 xf = *(const LAS bf16x8*)(XT + (16 * (t2 + e) + fr) * 72 + 32 * kk + 8 * fq); yd[e] = mfma16(af, xf, yd[e]); }
        }
#pragma unroll
        for (int e = 0; e < 2; ++e) { const int p = 16 * (t2 + e) + fr; const u32x2 xx = *(const LAS u32x2*)(XT + p * 72 + 16 * ti + 4 * fq);
            const float xv[4] = {bflo(xx.x), bfhi(xx.x), bflo(xx.y), bfhi(xx.y)};
#pragma unroll
            for (int r = 0; r < 4; ++r) { const int i = 16 * ti + 4 * fq + r; YS[i * 68 + p] = yd[e][r] + __expf(ai4[r]) * yoff[e][r] + dsk * xv[r]; } }
        {
            const float ea = __expf(SCa[63]);
#pragma unroll
            for (int a = 0; a < 4; ++a) hacc[a] = hacc[a] * ea;
#pragma unroll
            for (int kk = 0; kk < 2; ++kk) {
                const bf16x8 af = *(const LAS bf16x8*)(XWT + (16 * tp_s + fr) * 72 + 32 * kk + 8 * fq);
#pragma unroll
                for (int a = 0; a < 4; ++a) { const bf16x8 bf_ = *(const LAS bf16x8*)(BT + (16 * (tn0 + a) + fr) * 72 + 32 * kk + 8 * fq); hacc[a] = mfma16(af, bf_, hacc[a]); }
            }
#pragma unroll
            for (int a = 0; a < 4; ++a)
#pragma unroll
                for (int r = 0; r < 4; ++r) { const int p = 16 * tp_s + 4 * fq + r, n = 16 * (tn0 + a) + fr; HB[p * 136 + n] = (bf16)(pk2(hacc[a][r], 0.f) & 0xffffu); }
        }
        __syncthreads();
        {
            const f32x4 ya = *(const LAS f32x4*)(YS + zi * 68 + zp0), yb = *(const LAS f32x4*)(YS + zi * 68 + zp0 + 4);
            float yg[8];
            yg[0] = ya.x * bflo(zreg.x); yg[1] = ya.y * bfhi(zreg.x); yg[2] = ya.z * bflo(zreg.y); yg[3] = ya.w * bfhi(zreg.y);
            yg[4] = yb.x * bflo(zreg.z); yg[5] = yb.y * bfhi(zreg.z); yg[6] = yb.z * bflo(zreg.w); yg[7] = yb.w * bfhi(zreg.w);
            float ss = 0.f;
#pragma unroll
            for (int e = 0; e < 8; ++e) ss += yg[e] * yg[e];
            ss += __int_as_float(__builtin_amdgcn_update_dpp(0, __float_as_int(ss), 0xB1, 0xf, 0xf, false));
            ss += __int_as_float(__builtin_amdgcn_update_dpp(0, __float_as_int(ss), 0x4E, 0xf, 0xf, false));
            ss += __int_as_float(__builtin_amdgcn_update_dpp(0, __float_as_int(ss), 0x141, 0xf, 0xf, false));
            if (zi < nvalid) { const size_t row = (size_t)(row0 + c * 64 + zi);
                u32x4 o; o.x = pk2(yg[0], yg[1]); o.y = pk2(yg[2], yg[3]); o.z = pk2(yg[4], yg[5]); o.w = pk2(yg[6], yg[7]);
                *(u32x4*)(X.Y + row * D + h * 64 + zp0) = o;
                if ((tid & 7) < 2) X.SSQ2[row * 16 + h * 2 + (tid & 7)] = (tid & 7) == 0 ? ss : 0.f; }
        }
    }
    {
        float* so = X.out + (smp ? O_SS : O_SP) + (((size_t)(l * (smp ? DBT : NB) + b) * 8 + h) * 64) * 128;
#pragma unroll
        for (int a = 0; a < 4; ++a)
#pragma unroll
            for (int r = 0; r < 4; ++r) { const int p = 16 * tp_s + 4 * fq + r, n = 16 * (tn0 + a) + fr; so[(size_t)p * 128 + n] = hacc[a][r]; }
    }
    __syncthreads();
}

__device__ __forceinline__ void cmlp_unit(LAS unsigned char* L, const MixCtx& X, int l, int b, int kc, bool smp, int tid) {
    const int lane = tid & 63, wave = tid >> 6, fr = lane & 15, fq = lane >> 4;
    const int r0 = smp ? MP + b * DSQ : b * SEQ + kc * 128, Q = smp ? 16 : 128;
    LAS bf16* VT = (LAS bf16*)L;
    LAS bf16* STG = (LAS bf16*)(L + 139264) + wave * 1024;
    u32x4 vraw[16];
#pragma unroll
    for (int t = 0; t < 16; ++t) { const int j = 16 * wave + t; vraw[t] = (j < Q) ? *(const u32x4*)(X.P + (size_t)(r0 + j) * PW + 2048 + 8 * lane) : (u32x4){0u, 0u, 0u, 0u}; }
    float mean16[16], rstd16[16];
#pragma unroll
    for (int t4 = 0; t4 < 4; ++t4) {
        float s4[4], tot[4];
#pragma unroll
        for (int k = 0; k < 4; ++k) { const u32x4 r = vraw[4 * t4 + k]; s4[k] = ((bflo(r.x) + bfhi(r.x)) + (bflo(r.y) + bfhi(r.y))) + ((bflo(r.z) + bfhi(r.z)) + (bflo(r.w) + bfhi(r.w))); }
        reduce4(s4, lane, tot);
#pragma unroll
        for (int k = 0; k < 4; ++k) { const float m = tot[k] * (1.0f / 512.f); mean16[4 * t4 + k] = m; const u32x4 r = vraw[4 * t4 + k];
            const float d0 = bflo(r.x) - m, d1 = bfhi(r.x) - m, d2 = bflo(r.y) - m, d3 = bfhi(r.y) - m, d4 = bflo(r.z) - m, d5 = bfhi(r.z) - m, d6 = bflo(r.w) - m, d7 = bfhi(r.w) - m;
            s4[k] = ((d0 * d0 + d1 * d1) + (d2 * d2 + d3 * d3)) + ((d4 * d4 + d5 * d5) + (d6 * d6 + d7 * d7)); }
        reduce4(s4, lane, tot);
#pragma unroll
        for (int k = 0; k < 4; ++k) rstd16[4 * t4 + k] = rsqrtf(tot[k] * (1.0f / 512.f) + LN_EPS);
    }
    {
        const f32x4 g0 = *(const f32x4*)(X.v_ln_g + l * 512 + 8 * lane), g1 = *(const f32x4*)(X.v_ln_g + l * 512 + 8 * lane + 4);
        const f32x4 b0 = *(const f32x4*)(X.v_ln_b + l * 512 + 8 * lane), b1 = *(const f32x4*)(X.v_ln_b + l * 512 + 8 * lane + 4);
#pragma unroll
        for (int pr = 0; pr < 8; ++pr) {
#pragma unroll
            for (int hh = 0; hh < 2; ++hh) { const int t = 2 * pr + hh; const u32x4 r = vraw[t]; const float m = mean16[t], rs = rstd16[t];
                const f32x4 ya = (f32x4){(bflo(r.x) - m) * rs, (bfhi(r.x) - m) * rs, (bflo(r.y) - m) * rs, (bfhi(r.y) - m) * rs} * g0 + b0;
                const f32x4 yb = (f32x4){(bflo(r.z) - m) * rs, (bfhi(r.z) - m) * rs, (bflo(r.w) - m) * rs, (bfhi(r.w) - m) * rs} * g1 + b1;
                u32x4 o; o.x = pk2(ya.x, ya.y); o.y = pk2(ya.z, ya.w); o.z = pk2(yb.x, yb.y); o.w = pk2(yb.z, yb.w);
                *(LAS u32x4*)(STG + hh * 512 + 8 * lane) = o;
                if (smp && 16 * wave + t < Q) { float* vo = X.out + O_VS + ((size_t)(l * DBT + b) * DSQ + 16 * wave + t) * 512 + 8 * lane; *(f32x4*)vo = ya; *(f32x4*)(vo + 4) = yb; } }
            const int j0 = 16 * wave + 2 * pr;
#pragma unroll
            for (int e = 0; e < 8; ++e) { const int d = lane + 64 * e; const unsigned lo = STG[d], hi = STG[512 + d]; *(LAS unsigned*)(VT + d * 136 + j0) = lo | (hi << 16); }
        }
    }
    __syncthreads();
    const int g = wave >> 1, dt0 = (wave & 1) * 4;
    const bf16* wsg = X.WS + (size_t)(l * 4 + g) * 128 * 128;
    bf16x8 bw[20];
    {
        int idx = 0;
#pragma unroll
        for (int it2 = 0; it2 < 4; ++it2)
#pragma unroll
            for (int kk = 0; kk < 4; ++kk)
                if (kk <= it2) {
#pragma unroll
                    for (int e = 0; e < 2; ++e) { bw[idx] = *(const bf16x8*)(wsg + (size_t)(16 * (2 * it2 + e) + fr) * 128 + 32 * kk + 8 * fq); ++idx; } }
    }
    int bidx = 0;
#pragma unroll
    for (int it2 = 0; it2 < 4; ++it2) {
        if (smp && it2 > 0) break;
        u32x2 uu[4][2];
#pragma unroll
        for (int e = 0; e < 2; ++e) { const int i = min(16 * (2 * it2 + e) + fr, Q - 1);
#pragma unroll
            for (int a = 0; a < 4; ++a) uu[a][e] = *(const u32x2*)(X.P + (size_t)(r0 + i) * PW + 1536 + g * 128 + (dt0 + a) * 16 + 4 * fq); }
        f32x4 acc[4][2];
#pragma unroll
        for (int a = 0; a < 4; ++a)
#pragma unroll
            for (int e = 0; e < 2; ++e) acc[a][e] = (f32x4){0.f, 0.f, 0.f, 0.f};
#pragma unroll
        for (int kk = 0; kk < 4; ++kk) {
            if (kk <= it2) {
#pragma unroll
                for (int a = 0; a < 4; ++a) { const bf16x8 af = *(const LAS bf16x8*)(VT + (g * 128 + (dt0 + a) * 16 + fr) * 136 + 32 * kk + 8 * fq);
#pragma unroll
                    for (int e = 0; e < 2; ++e) acc[a][e] = mfma16(af, bw[bidx + e], acc[a][e]); }
                bidx += 2;
            }
        }
#pragma unroll
        for (int e = 0; e < 2; ++e) { const int i = 16 * (2 * it2 + e) + fr;
            if (i < Q) { const float bs = X.b_s[(l * 4 + g) * 128 + i];
#pragma unroll
                for (int a = 0; a < 4; ++a) { const int d = g * 128 + (dt0 + a) * 16 + 4 * fq; const u32x2 uv = uu[a][e];
                    u32x2 o; o.x = pk2(bflo(uv.x) * (acc[a][e][0] + bs), bfhi(uv.x) * (acc[a][e][1] + bs)); o.y = pk2(bflo(uv.y) * (acc[a][e][2] + bs), bfhi(uv.y) * (acc[a][e][3] + bs));
                    *(u32x2*)(X.Y + (size_t)(r0 + i) * D + 512 + d) = o; } } }
    }
    __syncthreads();
}

__device__ __forceinline__ void ssd_finalize(bf16* Y, const bf16* P, const float* gw_, int bid, int G, int tid) {
    const int lane = tid & 63, wave = tid >> 6;
    const f32x4 ga = *(const f32x4*)(gw_ + 8 * lane), gb = *(const f32x4*)(gw_ + 8 * lane + 4);
    for (int sl = bid * 8 + wave; sl < MV / 32; sl += G * 8) {
        for (int it = 0; it < 8; ++it) {
            const int rbase = sl * 32 + it * 4;
            bf16* yp = Y + (size_t)rbase * D + 8 * lane; const bf16* zp = P + (size_t)rbase * PW + 8 * lane;
            u32x4 yy[4], zz[4];
#pragma unroll
            for (int rr = 0; rr < 4; ++rr) { yy[rr] = __builtin_nontemporal_load((const u32x4*)(yp + rr * D)); zz[rr] = __builtin_nontemporal_load((const u32x4*)(zp + rr * PW)); }
            float v[4][8], ss[4], tot[4];
#pragma unroll
            for (int rr = 0; rr < 4; ++rr) {
                v[rr][0] = bflo(yy[rr].x) * silu_f(bflo(zz[rr].x)); v[rr][1] = bfhi(yy[rr].x) * silu_f(bfhi(zz[rr].x)); v[rr][2] = bflo(yy[rr].y) * silu_f(bflo(zz[rr].y)); v[rr][3] = bfhi(yy[rr].y) * silu_f(bfhi(zz[rr].y));
                v[rr][4] = bflo(yy[rr].z) * silu_f(bflo(zz[rr].z)); v[rr][5] = bfhi(yy[rr].z) * silu_f(bfhi(zz[rr].z)); v[rr][6] = bflo(yy[rr].w) * silu_f(bflo(zz[rr].w)); v[rr][7] = bfhi(yy[rr].w) * silu_f(bfhi(zz[rr].w));
                float a = 0.f;
#pragma unroll
                for (int e = 0; e < 8; ++e) a += v[rr][e] * v[rr][e];
                ss[rr] = a; }
            reduce4(ss, lane, tot);
#pragma unroll
            for (int rr = 0; rr < 4; ++rr) { const float rstd = rsqrtf(tot[rr] * (1.0f / 512.f) + RMS_EPS);
                u32x4 o; o.x = pk2(v[rr][0] * rstd * ga.x, v[rr][1] * rstd * ga.y); o.y = pk2(v[rr][2] * rstd * ga.z, v[rr][3] * rstd * ga.w);
                o.z = pk2(v[rr][4] * rstd * gb.x, v[rr][5] * rstd * gb.y); o.w = pk2(v[rr][6] * rstd * gb.z, v[rr][7] * rstd * gb.w);
                *(u32x4*)(yp + rr * D) = o; }
        }
    }
}

__device__ __forceinline__ f32x4 skinny_tile(const bf16* ap, const bf16* bp, int nkk = 32) {
    f32x4 acc = (f32x4){0.f, 0.f, 0.f, 0.f};
#pragma unroll 16
    for (int kk = 0; kk < nkk; ++kk) acc = mfma16(*(const bf16x8*)(bp + 32 * kk), *(const bf16x8*)(ap + 32 * kk), acc);
    return acc;
}
__device__ __forceinline__ void skinny_store(bf16* O, int N, int mt, int nt, int fr, int fq, int mode, f32x4 v) {
    const int act = (mode == 2) ? 2 : ((mode == 1 && (nt >> 4) >= 6) ? 1 : ((mode == 1 && (nt >> 4) < 2) ? 3 : 0));
    if (act == 1) {
#pragma unroll
        for (int j = 0; j < 4; ++j) v[j] = pg8::gelu_tanh_f(v[j]); }
    else if (act == 2) {
#pragma unroll
        for (int j = 0; j < 4; ++j) { const float a0 = fmaxf(v[j], 0.f); v[j] = a0 * a0; } }
    else if (act == 3) {
#pragma unroll
        for (int j = 0; j < 4; ++j) v[j] = silu_f(v[j]); }
    u32x2 o; o.x = pk2(v[0], v[1]); o.y = pk2(v[2], v[3]);
    *(u32x2*)(O + (size_t)(MP + 16 * mt + fr) * N + 16 * nt + 4 * fq) = o;
}
__device__ __forceinline__ void skinny_gemm(LAS unsigned char* L, const bf16* A, const bf16* Bt, int N, int K, bf16* O, int mode, const float* ssq, int bid, int G, int tid) {
    const int lane = tid & 63, wave = tid >> 6, fr = lane & 15, fq = lane >> 4;
    const int tiles = 8 * (N >> 4);
    if (K == 1024) {
        for (int t = bid * 8 + wave; t < tiles; t += G * 8) { const int mt = t & 7, nt = t >> 3;
            const bf16* ap = A + (size_t)(MP + 16 * mt + fr) * K + 8 * fq; const bf16* bp = Bt + (size_t)(16 * nt + fr) * K + 8 * fq;
            f32x4 acc;
            if (ssq != nullptr) {
                const float* sp = ssq + (size_t)(MP + 16 * mt + fr) * 16; const f32x4 s0 = *(const f32x4*)sp, s1 = *(const f32x4*)(sp + 4), s2 = *(const f32x4*)(sp + 8), s3 = *(const f32x4*)(sp + 12);
                const float tot = (((s0.x + s0.y) + (s0.z + s0.w)) + ((s1.x + s1.y) + (s1.z + s1.w))) + (((s2.x + s2.y) + (s2.z + s2.w)) + ((s3.x + s3.y) + (s3.z + s3.w)));
                acc = skinny_tile(ap, bp, 16) * rsqrtf(tot * (1.0f / 512.f) + RMS_EPS) + skinny_tile(ap + 512, bp + 512, 16);
            } else acc = skinny_tile(ap, bp);
            skinny_store(O, N, mt, nt, fr, fq, mode, acc); }
    } else {
        LAS f32x4* red = (LAS f32x4*)L;
        for (int tp = bid; tp * 2 < tiles; tp += G) { const int t = tp * 2 + (wave >> 2), ks = wave & 3, mt = t & 7, nt = t >> 3;
            const f32x4 acc = skinny_tile(A + (size_t)(MP + 16 * mt + fr) * K + ks * 1024 + 8 * fq, Bt + (size_t)(16 * nt + fr) * K + ks * 1024 + 8 * fq);
            red[wave * 64 + lane] = acc;
            __syncthreads();
            if (ks == 0) { const f32x4 v = (red[wave * 64 + lane] + red[(wave + 1) * 64 + lane]) + (red[(wave + 2) * 64 + lane] + red[(wave + 3) * 64 + lane]); skinny_store(O, N, mt, nt, fr, fq, mode, v); }
            __syncthreads(); }
    }
}

__global__ void __launch_bounds__(NTHR, 2) mega_fwd(Args a) {
    extern __shared__ __attribute__((aligned(16))) unsigned char lds_raw[];
    LAS unsigned char* L = (LAS unsigned char*)lds_raw;
    cg::grid_group grid = cg::this_grid();
    const int tid = threadIdx.x, bid = blockIdx.x, G = gridDim.x;
    unsigned char* ws = a.ws;
    bf16* Hb = (bf16*)(ws + WS_H); bf16* MF = (bf16*)(ws + WS_MF); bf16* BIG = (bf16*)(ws + WS_BIG);
    float* MOD = (float*)(ws + WS_MOD); float* DTb = (float*)(ws + WS_DT); bf16* XB = (bf16*)(ws + WS_XB);
    float* outp = a.out + O_YP; float* outs = a.out + O_YS;
    const float* norm_g = a.in[8];

    GBar gb; gb.w = (unsigned*)(ws + WS_SSQ); gb.gen = 0u; gb.xcc = (unsigned)__builtin_amdgcn_s_getreg((3 << 11) | 20) & 7u;
    if (tid == 0) __hip_atomic_fetch_add(gb.w + 1088 + 64 * gb.xcc, 1u, __ATOMIC_RELAXED, __HIP_MEMORY_SCOPE_AGENT);
    for (int rep = 0; rep < REP_PREP; ++rep) prep_phase(L, a, bid, G, hide(tid));
    grid.sync();
    { unsigned nx = 0u; gb.nloc = gb_ld(gb.w + 1088 + 64 * gb.xcc);
#pragma unroll
      for (int j = 0; j < 8; ++j) nx += gb_ld(gb.w + 1088 + 64 * j) != 0u ? 1u : 0u;
      gb.nx = nx; }

    for (int step = 0; step <= 4 * DEPTH; ++step) {
        const int l = step >> 2, st = step & 3;
        if (st == 0 || st == 2) {
            NormCfg c;
            if (st == 0) {
                if (l > 0) { const int lp = l - 1; c.mf = MF; c.gate = MOD + (size_t)lp * NSEQ * 6144 + 5 * 1024; c.ngpost = norm_g + (lp * 4 + 3) * 1024; c.xsrc_p = outp; c.xsrc_s = outs; c.xdst_p = outp; c.xdst_s = outs;
                    c.xb_src = XB; c.xb_dst = (l < DEPTH) ? XB : nullptr; }
                else { c.mf = nullptr; c.gate = nullptr; c.ngpost = nullptr; c.xsrc_p = a.in[0]; c.xsrc_s = a.in[1]; c.xdst_p = nullptr; c.xdst_s = nullptr; c.xb_src = nullptr; c.xb_dst = nullptr; }
                if (l < DEPTH) { c.ngpre = norm_g + (l * 4 + 0) * 1024; c.sc = MOD + (size_t)l * NSEQ * 6144 + 1 * 1024; c.sh = MOD + (size_t)l * NSEQ * 6144; c.H = Hb;
                    c.wdt = (const float*)(ws + WS_WDT) + (size_t)l * 8192; c.dtbias = a.in[12] + l * 8; c.DT = DTb; }
                else { c.ngpre = nullptr; c.sc = nullptr; c.sh = nullptr; c.H = nullptr; c.wdt = nullptr; c.dtbias = nullptr; c.DT = nullptr; }
            } else {
                c.mf = MF; c.gate = MOD + (size_t)l * NSEQ * 6144 + 2 * 1024; c.ngpost = norm_g + (l * 4 + 1) * 1024;
                c.xsrc_p = a.in[0]; c.xsrc_s = a.in[1]; c.xdst_p = outp; c.xdst_s = outs; c.xb_src = (l == 0) ? nullptr : XB; c.xb_dst = XB;
                c.ngpre = norm_g + (l * 4 + 2) * 1024; c.sc = MOD + (size_t)l * NSEQ * 6144 + 4 * 1024; c.sh = MOD + (size_t)l * NSEQ * 6144 + 3 * 1024; c.H = Hb;
                c.wdt = nullptr; c.dtbias = nullptr; c.DT = nullptr;
            }
            for (int rn = 0; rn < REP_NORM; ++rn) {
                NormCfg c2 = c; if (rn + 1 < REP_NORM) {
                    if (c2.xb_dst != nullptr) c2.xb_dst = BIG + (size_t)2 * MT * D; else { c2.xdst_p = (float*)BIG; c2.xdst_s = (float*)BIG + (size_t)MP * D; }
                    if (c2.H != nullptr) c2.H = BIG; if (c2.DT != nullptr) c2.DT = (float*)(BIG + (size_t)3 * MT * D); }
                if (c2.mf != nullptr || c2.ngpre != nullptr) norm_pass(L, c2, bid, G, hide(tid));
                if (rn + 1 < REP_NORM) GSYNC();
            }
            GSYNC();
        }
        if (step == 4 * DEPTH) break;
        if (st == 1) {
            MixCtx X; X.P = BIG; X.Y = Hb; X.DT = DTb; X.WS = (const bf16*)(ws + WS_WS); X.XC = MF; X.SSQ2 = (float*)(ws + WS_SSQ2);
            X.state_conv = a.in[2]; X.state_ssd = a.in[3]; X.conv_w = a.in[10]; X.conv_b = a.in[11]; X.a_log = a.in[13]; X.d_skip = a.in[14];
            X.v_ln_g = a.in[16]; X.v_ln_b = a.in[17]; X.b_s = a.in[19]; X.out = a.out;
            for (int rep = 0; rep < REP_CONV; ++rep)
            for (int u = bid; u < 1024 + 8; u += G) { const bool smp = u >= 1024; conv_unit(X, l, smp ? u - 1024 : (u >> 6), smp ? 0 : (u & 63), smp, hide(tid)); }
            GSYNC();
            {
                const int nj = G - 128;
                const int u0 = bid, ulim = bid < 128 ? 128 : 128 + 64 + 8 + 512, ustr = bid < 128 ? (1 << 20) : nj;
                for (int rep = 0; rep < REP_MIX; ++rep)
                for (int u = u0; u < ulim; u += ustr) {
                    if (u < 192) { const bool smp = u >= 128; const int v = u & 127;
                        const int cb_ = smp ? ((v >> 3) & 7) : ((v & 7) * 2 + (v >> 6)), ch_ = smp ? (v & 7) : ((v >> 3) & 7);
                        for (int r2 = 0; r2 < REP_SSD; ++r2) ssd_unit(L, X, l, cb_, ch_, smp, hide(tid)); }
                    else { const int v = u - 200; const bool smp = v < 0; for (int r2 = 0; r2 < REP_CMLP; ++r2) cmlp_unit(L, X, l, smp ? (u - 192) : (v >> 5), smp ? 0 : (v & 31), smp, hide(tid)); }
                }
            }
            if (bid >= 128 && l + 1 < DEPTH) { const int t2_ = hide(tid); prep_transposes(L, a, l + 1, l + 2, (bid - 128) * 8 + (t2_ >> 6), (G - 128) * 8, t2_ & 63, t2_ >> 6); }
            GSYNC();
        }
        {
            const bf16* A; const bf16* Bt; int N, K, mode; bf16* O;
            if (st == 0) { A = Hb; Bt = (const bf16*)(ws + WS_WIN) + (size_t)l * NIN * D; N = NIN; K = D; O = BIG; mode = 1; }
            else if (st == 1) { A = Hb; Bt = (const bf16*)(ws + WS_WOUT) + (size_t)l * D * D; N = D; K = D; O = MF; mode = 0; }
            else if (st == 2) { A = Hb; Bt = (const bf16*)(ws + WS_WFF1) + (size_t)l * DFF * D; N = DFF; K = D; O = BIG; mode = 2; }
            else { A = BIG; Bt = (const bf16*)(ws + WS_WFF2) + (size_t)l * D * DFF; N = D; K = DFF; O = MF; mode = 0; }
            pg8::Gemm gm{A, Bt, MP, N, K}; pg8::StaticOrder S; S.init(MP, N, G, bid);
            const float* ssq2 = (st == 1) ? (const float*)(ws + WS_SSQ2) : nullptr;
            LAS float* rtab = (LAS float*)(L + 131072);
            if (st == 1) {
                pg8::Unit u4[4]; bool ok4[4];
#pragma unroll
                for (int i = 0; i < 4; ++i) ok4[i] = S.next(i, u4[i]);
                if (tid < 256) {
                    const int tq = hide(tid); f32x4 sv[4][4];
#pragma unroll
                    for (int i = 0; i < 4; ++i) { const float* sp = ssq2 + (size_t)((ok4[i] ? u4[i].pm : 0) * 256 + tq) * 16;
#pragma unroll
                        for (int j = 0; j < 4; ++j) sv[i][j] = *(const f32x4*)(sp + 4 * j); }
#pragma unroll
                    for (int i = 0; i < 4; ++i) { const f32x4 s0 = sv[i][0], s1 = sv[i][1], s2 = sv[i][2], s3 = sv[i][3];
                        const float tot = (((s0.x + s0.y) + (s0.z + s0.w)) + ((s1.x + s1.y) + (s1.z + s1.w))) + (((s2.x + s2.y) + (s2.z + s2.w)) + ((s3.x + s3.y) + (s3.z + s3.w)));
                        rtab[i * 256 + tq] = rsqrtf(tot * (1.0f / 512.f) + RMS_EPS); }
                }
                { pg8::Unit uu;
                  for (int i = 4; i < 8 && S.next(i, uu); ++i)
                    if (tid < 256) { const int tq = hide(tid); const float* sp = ssq2 + (size_t)(uu.pm * 256 + tq) * 16; const f32x4 s0 = *(const f32x4*)sp, s1 = *(const f32x4*)(sp + 4), s2 = *(const f32x4*)(sp + 8), s3 = *(const f32x4*)(sp + 12);
                        const float tot = (((s0.x + s0.y) + (s0.z + s0.w)) + ((s1.x + s1.y) + (s1.z + s1.w))) + (((s2.x + s2.y) + (s2.z + s2.w)) + ((s3.x + s3.y) + (s3.z + s3.w)));
                        rtab[i * 256 + tq] = rsqrtf(tot * (1.0f / 512.f) + RMS_EPS); } }
                __syncthreads();
            }
            pg8::EpiAct E{O, N, mode | ((st == 1) ? 4 : 0), 6};
            for (int rep = 0; rep < REP_GEMM; ++rep) { pg8::gemm_phase<pg8::EpiAct, pg8::StaticOrder, true, true>(L, gm, S, E); skinny_gemm(L, A, Bt, N, K, O, mode, ssq2, bid, G, hide(tid)); }
            GSYNC();
        }
    }
}

extern "C" void kernel_launch(void* const* d_in, const int* in_sizes, int n_in, void* d_out, int out_size, void* d_ws, size_t ws_size, hipStream_t stream) {
    static int ready = 0;
    if (!ready) {
        if (n_in != 23 || ws_size < WS_END) { fprintf(stderr, "kernel_launch: unexpected n_in %d / ws_size %zu (need %zu)\n", n_in, ws_size, (size_t)WS_END); }
        if (hipFuncSetAttribute((const void*)mega_fwd, hipFuncAttributeMaxDynamicSharedMemorySize, LDS_BYTES) != hipSuccess) fprintf(stderr, "kernel_launch: hipFuncSetAttribute failed\n");
        int per_cu = 0;
        if (hipOccupancyMaxActiveBlocksPerMultiprocessor(&per_cu, (const void*)mega_fwd, NTHR, LDS_BYTES) != hipSuccess || per_cu < 1) fprintf(stderr, "kernel_launch: occupancy query says %d\n", per_cu);
        (void)hipGetLastError();
        ready = 1;
    }
    (void)hipMemsetAsync((unsigned char*)d_ws + WS_SSQ, 0, 8192, stream);
    Args a{};
    for (int i = 0; i < 23; ++i) a.in[i] = (const float*)d_in[i];
    a.out = (float*)d_out; a.ws = (unsigned char*)d_ws;
    void* args[] = {&a};
    hipError_t e = hipLaunchCooperativeKernel((const void*)mega_fwd, dim3(256), dim3(NTHR), args, LDS_BYTES, stream);
    if (e != hipSuccess) fprintf(stderr, "kernel_launch: cooperative launch failed: %s\n", hipGetErrorString(e));
}
```
